# Optimizing an MI355X kernel written in HIP

```python
import math
import jax, jax.numpy as jnp
from jax import lax
import numpy as np

D_MODEL = 1024
BATCH = 2
SEQ = 8192
DEPTH = 2

CHUNK = 64
Q_BLOCK = 128
F32 = jnp.float32

HEAD_DIM = 64
N_HEADS_SB = 8
N_HEADS_FOX = 8
FORGET_BIAS = 3.0

N_HEADS_DSA = 16
DSA_LATENT = 192
DSA_ROPE = 64
DSA_KEY_DIM = DSA_ROPE + DSA_LATENT
DSA_V_HEAD = 64
IDX_HEADS = 16
IDX_DIM = 64
IDX_TOPK = 256
IDX_SCALE = (IDX_HEADS * IDX_DIM) ** -0.5

ROPE_THETA = 500000.0
D_FF = 2816
CONV_WIDTH = 3
LN_EPS = 1e-5
ALPHA = (2 * DEPTH) ** 0.25
BETA = (8 * DEPTH) ** -0.25

W_IN_AB = 3 * (N_HEADS_SB + N_HEADS_FOX) * HEAD_DIM + N_HEADS_FOX
W_IN_C = N_HEADS_DSA * DSA_KEY_DIM + DSA_ROPE + DSA_LATENT + IDX_HEADS * IDX_DIM + IDX_DIM + IDX_HEADS

kernel_name = 'hybrid_stickbreak_fox_dsa_convffn'


def layer_norm(x, g, b):
    xf = x.astype(F32)
    mu = xf.mean(-1, keepdims=True)
    var = jnp.square(xf - mu).mean(-1, keepdims=True)
    y = (xf - mu) * lax.rsqrt(var + LN_EPS)
    return (y * g.astype(F32) + b.astype(F32)).astype(x.dtype)


def partial_rope(x, positions):
    d = x.shape[-1]
    rot = d // 4
    half = rot // 2
    freqs = ROPE_THETA ** (-jnp.arange(half, dtype=F32) / half)
    ang = positions.astype(F32)[..., None] * freqs
    ang = ang.reshape(ang.shape[:2] + (1,) * (x.ndim - 3) + (half,))
    cos, sin = jnp.cos(ang), jnp.sin(ang)
    xf = x.astype(F32)
    x1, x2, rest = xf[..., :half], xf[..., half:rot], xf[..., rot:]
    out = jnp.concatenate([x1 * cos - x2 * sin, x2 * cos + x1 * sin, rest], axis=-1)
    return out.astype(x.dtype)


def to_blocks(a):
    b, s = a.shape[:2]
    return a.reshape((b, s // Q_BLOCK, Q_BLOCK) + a.shape[2:]).swapaxes(0, 1)


def from_blocks(a):
    nb, b = a.shape[:2]
    return a.swapaxes(0, 1).reshape((b, nb * Q_BLOCK) + a.shape[3:])


def stick_breaking_attention(q, k, v):
    s_len, dh = q.shape[1], q.shape[3]
    scale = dh ** -0.5
    kf, vf = k.astype(F32), v.astype(F32)
    key_pos = jnp.arange(s_len)

    def block(args):
        i, qb = args
        qpos = i * Q_BLOCK + jnp.arange(Q_BLOCK)
        mask = key_pos[None, :] < qpos[:, None]
        z = jnp.einsum('bqhd,bshd->bhqs', qb.astype(F32), kf) * scale
        log_stay = jnp.where(mask, jax.nn.log_sigmoid(-z), 0.0)
        after = lax.cumsum(log_stay, axis=3, reverse=True) - log_stay
        w = jnp.where(mask, jnp.exp(jax.nn.log_sigmoid(z) + after), 0.0)
        return jnp.einsum('bhqs,bshd->bqhd', w, vf)

    out = lax.map(block, (jnp.arange(s_len // Q_BLOCK), to_blocks(q)))
    return from_blocks(out).astype(q.dtype)


def forgetting_attention(q, k, v, f_logit):
    s_len, dh = q.shape[1], q.shape[3]
    scale = dh ** -0.5
    kf, vf = k.astype(F32), v.astype(F32)
    cum = jnp.cumsum(jax.nn.log_sigmoid(f_logit.astype(F32)), axis=1)
    cum_k = cum.transpose(0, 2, 1)
    key_pos = jnp.arange(s_len)

    def block(args):
        i, qb, cq = args
        qpos = i * Q_BLOCK + jnp.arange(Q_BLOCK)
        mask = key_pos[None, :] <= qpos[:, None]
        logits = (jnp.einsum('bqhd,bshd->bhqs', qb.astype(F32), kf) * scale
                  + cq.transpose(0, 2, 1)[..., None] - cum_k[:, :, None, :])
        p = jax.nn.softmax(jnp.where(mask, logits, -jnp.inf), axis=-1)
        return jnp.einsum('bhqs,bshd->bqhd', p, vf)

    out = lax.map(block, (jnp.arange(s_len // Q_BLOCK), to_blocks(q), to_blocks(cum)))
    return from_blocks(out).astype(q.dtype)


def dsa_attention(q, k_lat, q_idx, k_idx, w_idx):
    s_len = q.shape[1]
    topk = min(IDX_TOPK, s_len // 4)
    scale = DSA_KEY_DIM ** -0.5
    klf, kif = k_lat.astype(F32), k_idx.astype(F32)
    key_pos = jnp.arange(s_len)

    def block(args):
        i, qb, qib, wb = args
        qpos = i * Q_BLOCK + jnp.arange(Q_BLOCK)
        visible = key_pos[None, :] < (qpos[:, None] // CHUNK + 1) * CHUNK
        idx_logits = jax.nn.relu(jnp.einsum('bqhd,bsd->bqhs', qib.astype(F32), kif))
        score = jnp.einsum('bqh,bqhs->bqs', wb.astype(F32), idx_logits) * IDX_SCALE
        score = jnp.where(visible[None], score, -jnp.inf)
        top_val, top_idx = lax.top_k(score, topk)
        valid = jnp.isfinite(top_val)
        k_sel = jax.vmap(lambda kb, ib: kb[ib])(klf, top_idx)
        logits = jnp.einsum('bqhd,bqkd->bqhk', qb.astype(F32), k_sel) * scale
        p = jax.nn.softmax(jnp.where(valid[:, :, None, :], logits, -jnp.inf), axis=-1)
        return jnp.einsum('bqhk,bqkc->bqhc', p, k_sel[..., DSA_ROPE:])

    out = lax.map(block, (jnp.arange(s_len // Q_BLOCK), to_blocks(q), to_blocks(q_idx), to_blocks(w_idx)))
    return from_blocks(out).astype(q.dtype)


def mixer_sb_fox(x, w_in, b_f, w_o):
    b, s, _ = x.shape
    gw = N_HEADS_SB * HEAD_DIM
    h = x @ w_in
    parts = jnp.split(h, [gw, 2 * gw, 3 * gw, 4 * gw, 5 * gw, 6 * gw], axis=-1)
    qa, ka, va = [p.reshape(b, s, N_HEADS_SB, HEAD_DIM) for p in parts[:3]]
    qb, kb, vb = [p.reshape(b, s, N_HEADS_FOX, HEAD_DIM) for p in parts[3:6]]
    f_logit = parts[6] + b_f
    oa = stick_breaking_attention(qa, ka, va).reshape(b, s, -1)
    ob = forgetting_attention(qb, kb, vb, f_logit).reshape(b, s, -1)
    return jnp.concatenate([oa, ob], axis=-1) @ w_o


def mixer_dsa(x, positions, w_in, w_uv, w_o):
    b, s, _ = x.shape
    h = x @ w_in
    c0 = N_HEADS_DSA * DSA_KEY_DIM
    c1 = c0 + DSA_ROPE
    c2 = c1 + DSA_LATENT
    c3 = c2 + IDX_HEADS * IDX_DIM
    c4 = c3 + IDX_DIM
    q, k_r, c_lat, q_idx, k_idx, w_idx = jnp.split(h, [c0, c1, c2, c3, c4], axis=-1)
    q = partial_rope(q.reshape(b, s, N_HEADS_DSA, DSA_KEY_DIM), positions)
    k_lat = partial_rope(jnp.concatenate([k_r, c_lat], axis=-1), positions)
    q_idx = partial_rope(q_idx.reshape(b, s, IDX_HEADS, IDX_DIM), positions)
    k_idx = partial_rope(k_idx, positions)
    ctx = dsa_attention(q, k_lat, q_idx, k_idx, w_idx)
    o = jnp.einsum('bshc,hcd->bshd', ctx, w_uv).reshape(b, s, -1)
    return o @ w_o


def conv_ffn(x, w_up, conv_w, conv_b, w_down):
    s = x.shape[1]
    gate, up = jnp.split(x @ w_up, 2, axis=-1)
    gp = jnp.pad(gate, ((0, 0), (CONV_WIDTH - 1, 0), (0, 0)))
    conv = conv_b + conv_w[0] * gp[:, 0:s]
    for j in range(1, CONV_WIDTH):
        conv = conv + conv_w[j] * gp[:, j:j + s]
    return (jax.nn.gelu(conv) * up) @ w_down


def setup_inputs(seed: int = 0) -> dict:
    key = jax.random.key(seed)
    ks = jax.random.split(key, 32)
    nrm = lambda k, shape, scale: jax.random.normal(k, shape, F32) * scale
    offsets = jax.random.randint(ks[1], (BATCH, 1), 0, 4096, dtype=jnp.int32)
    positions = (offsets + jnp.arange(SEQ, dtype=jnp.int32)[None, :]).astype(jnp.int32)
    inp = {'x': nrm(ks[0], (BATCH, SEQ, D_MODEL), 1.0), 'positions': positions}
    d_in = D_MODEL ** -0.5
    inp['l0_w_in'] = nrm(ks[2], (D_MODEL, W_IN_AB), d_in)
    inp['l0_b_f'] = FORGET_BIAS + nrm(ks[3], (N_HEADS_FOX,), 0.1)
    inp['l0_w_o'] = nrm(ks[4], (D_MODEL, D_MODEL), d_in * BETA)
    inp['l0_ln1_g'] = 1.0 + nrm(ks[5], (D_MODEL,), 0.02)
    inp['l0_ln1_b'] = nrm(ks[6], (D_MODEL,), 0.02)
    inp['l0_w_up'] = nrm(ks[7], (D_MODEL, 2 * D_FF), d_in)
    inp['l0_conv_w'] = nrm(ks[8], (CONV_WIDTH, D_FF), CONV_WIDTH ** -0.5)
    inp['l0_conv_b'] = nrm(ks[9], (D_FF,), 0.02)
    inp['l0_w_down'] = nrm(ks[10], (D_FF, D_MODEL), D_FF ** -0.5 * BETA)
    inp['l0_ln2_g'] = 1.0 + nrm(ks[11], (D_MODEL,), 0.02)
    inp['l0_ln2_b'] = nrm(ks[12], (D_MODEL,), 0.02)
    inp['l1_w_in'] = nrm(ks[13], (D_MODEL, W_IN_C), d_in)
    inp['l1_w_uv'] = nrm(ks[14], (N_HEADS_DSA, DSA_LATENT, DSA_V_HEAD), DSA_LATENT ** -0.5)
    inp['l1_w_o'] = nrm(ks[15], (N_HEADS_DSA * DSA_V_HEAD, D_MODEL), (N_HEADS_DSA * DSA_V_HEAD) ** -0.5 * BETA)
    inp['l1_ln1_g'] = 1.0 + nrm(ks[16], (D_MODEL,), 0.02)
    inp['l1_ln1_b'] = nrm(ks[17], (D_MODEL,), 0.02)
    inp['l1_w_up'] = nrm(ks[18], (D_MODEL, 2 * D_FF), d_in)
    inp['l1_conv_w'] = nrm(ks[19], (CONV_WIDTH, D_FF), CONV_WIDTH ** -0.5)
    inp['l1_conv_b'] = nrm(ks[20], (D_FF,), 0.02)
    inp['l1_w_down'] = nrm(ks[21], (D_FF, D_MODEL), D_FF ** -0.5 * BETA)
    inp['l1_ln2_g'] = 1.0 + nrm(ks[22], (D_MODEL,), 0.02)
    inp['l1_ln2_b'] = nrm(ks[23], (D_MODEL,), 0.02)
    return inp


def reference(x, positions,
              l0_w_in, l0_b_f, l0_w_o, l0_ln1_g, l0_ln1_b,
              l0_w_up, l0_conv_w, l0_conv_b, l0_w_down, l0_ln2_g, l0_ln2_b,
              l1_w_in, l1_w_uv, l1_w_o, l1_ln1_g, l1_ln1_b,
              l1_w_up, l1_conv_w, l1_conv_b, l1_w_down, l1_ln2_g, l1_ln2_b):
    mixer_params = [(l0_w_in, l0_b_f, l0_w_o), (l1_w_in, l1_w_uv, l1_w_o)]
    norm1 = [(l0_ln1_g, l0_ln1_b), (l1_ln1_g, l1_ln1_b)]
    ffn_params = [(l0_w_up, l0_conv_w, l0_conv_b, l0_w_down), (l1_w_up, l1_conv_w, l1_conv_b, l1_w_down)]
    norm2 = [(l0_ln2_g, l0_ln2_b), (l1_ln2_g, l1_ln2_b)]
    for i in range(DEPTH):
        if i % 2 == 0:
            m = mixer_sb_fox(x, *mixer_params[i])
        else:
            m = mixer_dsa(x, positions, *mixer_params[i])
        x = layer_norm(ALPHA * x + m, *norm1[i])
        x = layer_norm(ALPHA * x + conv_ffn(x, *ffn_params[i]), *norm2[i])
    return x
```

```cpp
#include <hip/hip_runtime.h>
#include <cstdio>
#include <cstdint>
namespace pg8 {
#define PG8_LAS __attribute__((address_space(3)))
typedef unsigned short bf16_t;
typedef short bf16x8 __attribute__((ext_vector_type(8)));
typedef float f32x4 __attribute__((ext_vector_type(4)));
typedef unsigned u32x4 __attribute__((ext_vector_type(4)));
constexpr int BM = 256, BK = 64, HALF = 128, HTB = HALF * BK * 2  , STAGE_BYTES = 8 * HTB, NXCD = 8, WGM = 8;

__host__ __device__ __forceinline__ int lds_byte(int r, int c) { const int st = (r >> 4) * 2 + (c >> 5), rr = r & 15, cc = c & 31, ob = rr * 64 + cc * 2; return st * 1024 + (ob ^ (((ob >> 9) & 1) << 5)); }
__host__ __device__ __forceinline__ void stage_rc(int b, int& R, int& C) { const int st = b / 1024, sb = b % 1024, swz = sb ^ (((sb >> 9) & 1) << 5); R = (st >> 1) * 16 + swz / 64; C = (st & 1) * 32 + (swz % 64) / 2; }
__host__ __device__ __forceinline__ int perm32(int rho) { const int n = rho >> 4, i = rho & 15; return 8 * (i >> 2) + 4 * n + (i & 3); }

struct Unit { int pm, pn; };
struct Gemm { const bf16_t* A; const bf16_t* Bt; int M, N, K, lda; };

struct StaticOrder {
    int nM, nN, nwg, G, c;
    __host__ __device__ void init(int M, int N, int G_, int c_) { nM = M / BM; nN = N / BM; nwg = nM * nN; G = G_; c = c_; }
    __host__ __device__ bool next(int i, Unit& u) const {
        const long L = (long)i * G + c; if (L >= nwg) return false;
        int wgid = (int)L; { const int q = nwg / NXCD, r = nwg % NXCD, xcd = wgid % NXCD, off = wgid / NXCD; wgid = (xcd < r ? xcd * (q + 1) : r * (q + 1) + (xcd - r) * q) + off; }
        const int nig = WGM * nN, gid = wgid / nig, fm = gid * WGM, gsz = (nM - fm) < WGM ? (nM - fm) : WGM;
        u.pm = fm + ((wgid % nig) % gsz); u.pn = (wgid % nig) / gsz; return true;
    }
    __device__ __forceinline__ void a_ready(const Unit&) const {}
    __device__ __forceinline__ void done(const Unit&) const {}
};

__device__ __forceinline__ unsigned cvt_pk_bf16(float lo, float hi) { unsigned r; asm volatile("v_cvt_pk_bf16_f32 %0, %1, %2" : "=v"(r) : "v"(lo), "v"(hi)); return r; }
typedef float f32x2 __attribute__((ext_vector_type(2)));
__device__ __forceinline__ f32x2 gelu_pk(f32x2 v) {
    const f32x2 av = __builtin_elementwise_abs(v), d = av * 0.2316418882f + 1.0f;
    f32x2 t; t.x = __builtin_amdgcn_rcpf(d.x); t.y = __builtin_amdgcn_rcpf(d.y);
    f32x2 q = t * 0.5307027145f + (-0.7265760135f); q = q * t + 0.7107068705f; q = q * t + (-0.142248368f); q = q * t + 0.127414796f; q = q * t;
    const f32x2 s = (v * v) * (-0.72134752044f);
    f32x2 e; e.x = __builtin_amdgcn_exp2f(s.x); e.y = __builtin_amdgcn_exp2f(s.y);
    const f32x2 m = v * (q * e), r = v - m;
    f32x2 o; o.x = v.x < 0.f ? m.x : r.x; o.y = v.y < 0.f ? m.y : r.y; return o;
}

template <int ACT  > struct EpiBf16 {
    static constexpr bool PERM = true, AFTER_DRAIN = false; static_assert(ACT == 0 || ACT == 1, "EpiBf16: ACT is 0 (none) or 1 (gelu_pk)");
    bf16_t* O; int ldc; const float* bias; int split_cols; size_t split_stride; float scale0;
    __device__ __forceinline__ void operator()(const f32x4 (&acc)[2][2][4][2], const Unit& u, int wr, int wc, int fr, int fq) const {
        const int row0 = u.pm * BM + wr * 64 + fr; int colt = u.pn * BM; bf16_t* base = O;
        float sc = 1.f; if (split_cols) { const int t = colt / split_cols; base += (size_t)t * split_stride; colt -= t * split_cols; if (t == 0) sc = scale0; }
        const int col0 = colt + wc * 32 + 8 * fq, bcol0 = u.pn * BM + wc * 32 + 8 * fq;
        f32x4 bv[2][2];
#pragma unroll
        for (int bj = 0; bj < 2; ++bj)
#pragma unroll
            for (int n = 0; n < 2; ++n) bv[bj][n] = bias ? *(const f32x4*)(bias + bcol0 + bj * HALF + 4 * n) : (f32x4){0.f, 0.f, 0.f, 0.f};
#pragma unroll
        for (int ai = 0; ai < 2; ++ai)
#pragma unroll
            for (int m = 0; m < 4; ++m) { bf16_t* rowp = base + (size_t)(row0 + ai * HALF + m * 16) * ldc + col0;
#pragma unroll
                for (int bj = 0; bj < 2; ++bj) { f32x4 v0 = acc[ai][bj][m][0] + bv[bj][0], v1 = acc[ai][bj][m][1] + bv[bj][1];
                    if (ACT == 1) { f32x2 a = gelu_pk((f32x2){v0[0], v0[1]}), b = gelu_pk((f32x2){v0[2], v0[3]}), c = gelu_pk((f32x2){v1[0], v1[1]}), d = gelu_pk((f32x2){v1[2], v1[3]});
                        v0 = (f32x4){a.x, a.y, b.x, b.y}; v1 = (f32x4){c.x, c.y, d.x, d.y}; }
                    v0 = v0 * sc; v1 = v1 * sc; u32x4 w; w.x = cvt_pk_bf16(v0[0], v0[1]); w.y = cvt_pk_bf16(v0[2], v0[3]); w.z = cvt_pk_bf16(v1[0], v1[1]); w.w = cvt_pk_bf16(v1[2], v1[3]);
                    *(u32x4*)(rowp + bj * HALF) = w; } }
    }
};
template <class Epi, class Sched, bool ALIGN_EPI = false, bool SP2 = false>
__device__ __forceinline__ void gemm_phase(PG8_LAS unsigned char* lds, const Gemm g, const Sched& S, const Epi& E) {
    int tid_ = threadIdx.x; asm volatile("" : "+v"(tid_));
    const int tid = tid_, wid = __builtin_amdgcn_readfirstlane(tid >> 6), lane = tid & 63, wr = wid >> 2, wc = wid & 3, fr = lane & 15, fq = lane >> 4;
    const int K = g.K, nt = K / BK;
    unsigned voffA[2], voffB[2];
#pragma unroll
    for (int i = 0; i < 2; ++i) { int R, C; stage_rc(tid * 16 + i * 8192, R, C); const int Rb = Epi::PERM ? ((R & ~31) + perm32(R & 31)) : R;
        voffA[i] = (unsigned)(R * g.lda + C) * 2u; voffB[i] = (unsigned)(Rb * K + C) * 2u; }
    const size_t kstep = (size_t)(BK * 2);
    const size_t hstepB = (size_t)HALF * K * 2, hstepA = (size_t)HALF * g.lda * 2;
    const size_t tstepA = 2 * hstepA, tstepB = 2 * hstepB;
    const unsigned ldsw = (unsigned)wid * 1024u;
    const int aoff = lds_byte(wr * 64 + fr, fq * 8), boff = lds_byte(wc * 32 + fr, fq * 8);
#define PG8_SA(b, h) (((b) * 2 + (h)) * HTB)
#define PG8_SB(b, h) ((4 + (b) * 2 + (h)) * HTB)
#define PG8_STAGE(bufoff, gbase, voff) do { _Pragma("unroll") for (int _i = 0; _i < 2; ++_i) \
        __builtin_amdgcn_global_load_lds((const unsigned*)((const char*)(gbase) + (voff)[_i]), (PG8_LAS unsigned*)(lds + (bufoff) + ldsw + _i * 8192), 16, 0, 0); } while (0)
#define PG8_LDA(dst, b, h) do { _Pragma("unroll") for (int m = 0; m < 4; ++m) _Pragma("unroll") for (int k = 0; k < 2; ++k) dst[m][k] = *(const PG8_LAS bf16x8*)(lds + PG8_SA(b, h) + aoff + m * 2048 + k * 1024); } while (0)
#define PG8_LDB(dst, b, h) do { _Pragma("unroll") for (int n = 0; n < 2; ++n) _Pragma("unroll") for (int k = 0; k < 2; ++k) dst[n][k] = *(const PG8_LAS bf16x8*)(lds + PG8_SB(b, h) + boff + n * 2048 + k * 1024); } while (0)
#define PG8_MMA(ai, bj, At, Bt) do { __builtin_amdgcn_s_setprio(1); _Pragma("unroll") for (int m = 0; m < 4; ++m) _Pragma("unroll") for (int n = 0; n < 2; ++n) _Pragma("unroll") for (int k = 0; k < 2; ++k) \
        acc[ai][bj][m][n] = __builtin_amdgcn_mfma_f32_16x16x32_bf16(Bt[n][k], At[m][k], acc[ai][bj][m][n], 0, 0, 0); __builtin_amdgcn_s_setprio(0); } while (0)
#define PG8_WAIT_V(n) asm volatile("s_waitcnt vmcnt(" #n ")" ::: "memory")
#define PG8_WAIT_L(n) asm volatile("s_waitcnt lgkmcnt(" #n ")" ::: "memory")
#define PG8_BAR __builtin_amdgcn_s_barrier()
#define PG8_SCHED __builtin_amdgcn_sched_barrier(0)
    Unit cur, nxt; int ui = 0;
    if (!S.next(0, cur)) return;
    f32x4 acc[2][2][4][2];
#pragma unroll
    for (int a = 0; a < 2; ++a)
#pragma unroll
        for (int b = 0; b < 2; ++b)
#pragma unroll
            for (int m = 0; m < 4; ++m)
#pragma unroll
                for (int n = 0; n < 2; ++n) acc[a][b][m][n] = (f32x4){0.f, 0.f, 0.f, 0.f};
    bf16x8 At[4][2], B0[2][2], B1[2][2];
    const char* cA = (const char*)g.A + (size_t)cur.pm * tstepA; const char* cB = (const char*)g.Bt + (size_t)cur.pn * tstepB;
    S.a_ready(cur);
    if constexpr (SP2) {
        PG8_STAGE(PG8_SB(0, 0), cB, voffB); PG8_STAGE(PG8_SB(0, 1), cB + hstepB, voffB); PG8_STAGE(PG8_SA(0, 0), cA, voffA); PG8_STAGE(PG8_SA(0, 1), cA + hstepA, voffA);
        if (wr == 1) PG8_BAR;
        PG8_WAIT_V(2); PG8_BAR;
        PG8_STAGE(PG8_SB(1, 0), cB + kstep, voffB); PG8_STAGE(PG8_SA(1, 0), cA + kstep, voffA); PG8_STAGE(PG8_SB(1, 1), cB + hstepB + kstep, voffB);
        PG8_WAIT_V(6); PG8_BAR;
    } else {
        PG8_STAGE(PG8_SB(0, 0), cB, voffB); PG8_STAGE(PG8_SA(0, 0), cA, voffA); PG8_STAGE(PG8_SB(0, 1), cB + hstepB, voffB); PG8_STAGE(PG8_SA(0, 1), cA + hstepA, voffA);
        if (wr == 1) PG8_BAR;
        PG8_WAIT_V(4); PG8_BAR;
        PG8_STAGE(PG8_SB(1, 0), cB + kstep, voffB); PG8_STAGE(PG8_SA(1, 0), cA + kstep, voffA); PG8_STAGE(PG8_SB(1, 1), cB + hstepB + kstep, voffB);
        PG8_WAIT_V(6); PG8_BAR;
    }
    for (;;) {
        const bool has_next = S.next(ui + 1, nxt);
        const char* nA = has_next ? (const char*)g.A + (size_t)nxt.pm * tstepA : cA; const char* nB = has_next ? (const char*)g.Bt + (size_t)nxt.pn * tstepB : cB;
        for (int t = 0; t < nt; t += 2) {
            const bool last = (t == nt - 2);
            const char* a1 = cA + (size_t)(t + 1) * kstep;
            const char* a2 = last ? nA : cA + (size_t)(t + 2) * kstep; const char* b2 = last ? nB : cB + (size_t)(t + 2) * kstep;
            const char* a3 = a2 + kstep; const char* b3 = b2 + kstep;
            if (last && has_next) S.a_ready(nxt);
            if constexpr (SP2) {
            PG8_LDB(B0, 0, 0); PG8_LDB(B1, 0, 1); PG8_SCHED; PG8_LDA(At, 0, 0); PG8_STAGE(PG8_SA(1, 1), a1 + hstepA, voffA);
            PG8_WAIT_V(8); PG8_WAIT_L(0); PG8_BAR; PG8_MMA(0, 0, At, B0); PG8_MMA(0, 1, At, B1); PG8_BAR; PG8_SCHED;
            PG8_LDA(At, 0, 1); PG8_STAGE(PG8_SB(0, 0), b2, voffB); PG8_STAGE(PG8_SB(0, 1), b2 + hstepB, voffB); PG8_STAGE(PG8_SA(0, 0), a2, voffA);
            PG8_WAIT_V(8); PG8_WAIT_L(0); PG8_BAR; PG8_MMA(1, 0, At, B0); PG8_MMA(1, 1, At, B1); PG8_BAR; PG8_SCHED;
            PG8_LDB(B0, 1, 0); PG8_LDB(B1, 1, 1); PG8_SCHED; PG8_LDA(At, 1, 0); PG8_STAGE(PG8_SA(0, 1), a2 + hstepA, voffA);
            PG8_WAIT_V(8); PG8_WAIT_L(0); PG8_BAR; PG8_MMA(0, 0, At, B0); PG8_MMA(0, 1, At, B1); PG8_BAR; PG8_SCHED;
            PG8_LDA(At, 1, 1); PG8_STAGE(PG8_SB(1, 0), b3, voffB); PG8_STAGE(PG8_SB(1, 1), b3 + hstepB, voffB); PG8_STAGE(PG8_SA(1, 0), a3, voffA);
            PG8_WAIT_V(8); PG8_WAIT_L(0); PG8_BAR; PG8_MMA(1, 0, At, B0); PG8_MMA(1, 1, At, B1); PG8_BAR; PG8_SCHED;
            } else {
            PG8_LDB(B0, 0, 0); PG8_SCHED; PG8_LDA(At, 0, 0); PG8_STAGE(PG8_SA(1, 1), a1 + hstepA, voffA);
            PG8_WAIT_L(8); PG8_BAR; PG8_WAIT_L(0); PG8_MMA(0, 0, At, B0); PG8_BAR; PG8_SCHED;
            PG8_LDB(B1, 0, 1); PG8_STAGE(PG8_SB(0, 0), b2, voffB);
            PG8_BAR; PG8_WAIT_L(0); PG8_MMA(0, 1, At, B1); PG8_BAR;
            PG8_LDA(At, 0, 1); PG8_STAGE(PG8_SA(0, 0), a2, voffA);
            PG8_BAR; PG8_WAIT_L(0); PG8_MMA(1, 0, At, B0); PG8_BAR; PG8_SCHED;
            PG8_STAGE(PG8_SB(0, 1), b2 + hstepB, voffB);
            PG8_WAIT_V(6); PG8_BAR; PG8_MMA(1, 1, At, B1); PG8_BAR;
            PG8_LDB(B0, 1, 0); PG8_SCHED; PG8_LDA(At, 1, 0); PG8_STAGE(PG8_SA(0, 1), a2 + hstepA, voffA);
            PG8_WAIT_L(8); PG8_BAR; PG8_WAIT_L(0); PG8_MMA(0, 0, At, B0); PG8_BAR; PG8_SCHED;
            PG8_LDB(B1, 1, 1); PG8_STAGE(PG8_SB(1, 0), b3, voffB);
            PG8_BAR; PG8_WAIT_L(0); PG8_MMA(0, 1, At, B1); PG8_BAR;
            PG8_LDA(At, 1, 1); PG8_STAGE(PG8_SA(1, 0), a3, voffA);
            PG8_BAR; PG8_WAIT_L(0); PG8_MMA(1, 0, At, B0); PG8_BAR; PG8_SCHED;
            PG8_STAGE(PG8_SB(1, 1), b3 + hstepB, voffB);
            PG8_WAIT_V(6); PG8_BAR; PG8_MMA(1, 1, At, B1); PG8_BAR;
            }
        }
        if constexpr (ALIGN_EPI) { if (wr == 0) PG8_BAR; }
        if constexpr (!Epi::AFTER_DRAIN) { E(acc, cur, wr, wc, fr, fq); S.done(cur); }
        if (!has_next) break;
#pragma unroll
        for (int a = 0; a < 2; ++a)
#pragma unroll
            for (int b = 0; b < 2; ++b)
#pragma unroll
                for (int m = 0; m < 4; ++m)
#pragma unroll
                    for (int n = 0; n < 2; ++n) acc[a][b][m][n] = (f32x4){0.f, 0.f, 0.f, 0.f};
        cur = nxt; cA = nA; cB = nB; ++ui;
        if constexpr (ALIGN_EPI) { if (wr == 1) PG8_BAR; }
    }
    PG8_WAIT_V(0);
    if constexpr (!ALIGN_EPI) { if (wr == 0) PG8_BAR; }
    PG8_BAR;
    if constexpr (Epi::AFTER_DRAIN) { E.fused(acc, cur, wr, wc, fr, fq, lds, wid, lane); S.done(cur); }
#undef PG8_SA
#undef PG8_SB
#undef PG8_STAGE
#undef PG8_LDA
#undef PG8_LDB
#undef PG8_MMA
#undef PG8_WAIT_V
#undef PG8_WAIT_L
#undef PG8_BAR
#undef PG8_SCHED
}
}

#ifndef PG8_SP2
#define PG8_SP2 true
#endif
#ifndef PG8_ALIGN
#define PG8_ALIGN true
#endif
namespace pg8 {
struct EpiResF32 {
    static constexpr bool PERM = false, AFTER_DRAIN = false;
    const float* base; float* out; int ldc; float alpha;
    __device__ __forceinline__ void operator()(const f32x4 (&acc)[2][2][4][2], const Unit& u, int wr, int wc, int fr, int fq) const {
        const int col0 = u.pn * BM + wc * 32 + 4 * fq;
#pragma unroll
        for (int ai = 0; ai < 2; ++ai)
#pragma unroll
            for (int m = 0; m < 4; ++m) { const size_t off = (size_t)(u.pm * BM + ai * HALF + wr * 64 + m * 16 + fr) * ldc + col0;
#pragma unroll
                for (int bj = 0; bj < 2; ++bj)
#pragma unroll
                    for (int n = 0; n < 2; ++n) { const f32x4 bs = *(const f32x4*)(base + off + bj * HALF + n * 16); *(f32x4*)(out + off + bj * HALF + n * 16) = bs * alpha + acc[ai][bj][m][n]; }
                asm volatile("" ::: "memory"); }
    }
};
struct EpiL1In {
    static constexpr bool PERM = true, AFTER_DRAIN = false;
    bf16_t *Qd, *KL, *QI, *KI; float* WI; const float* csq; const float* csi; float wscale;
    __device__ __forceinline__ void operator()(const f32x4 (&acc)[2][2][4][2], const Unit& u, int wr, int wc, int fr, int fq) const {
        const int pn = u.pn, row0 = u.pm * BM + wr * 64 + fr;
#pragma unroll
        for (int bj = 0; bj < 2; ++bj) {
            const int c0 = bj * HALF + wc * 32 + 8 * fq;
            int kind = 0, pb = 0, ld = 0, dcol = 0; bf16_t* dst = nullptr; bool f32out = false, skip = false;
            if (pn < 16) { dst = Qd; ld = 4096; dcol = pn * 256 + c0; kind = c0 < 64 ? 1 : 0; pb = c0 >> 1; }
            else if (pn == 16) { dst = KL; ld = 256; dcol = c0; kind = c0 < 64 ? 1 : 0; pb = c0 >> 1; }
            else if (pn < 21) { dst = QI; ld = 1024; dcol = (pn - 17) * 256 + c0; const int j0 = c0 & 63; kind = j0 < 16 ? 2 : 0; pb = j0 >> 1; }
            else { if (c0 < 64) { dst = KI; ld = 64; dcol = c0; kind = c0 < 16 ? 2 : 0; pb = c0 >> 1; } else if (c0 < 80) { f32out = true; dcol = c0 - 64; } else skip = true; }
            if (skip) continue;
#pragma unroll
            for (int ai = 0; ai < 2; ++ai)
#pragma unroll
                for (int m = 0; m < 4; ++m) { const int row = row0 + ai * HALF + m * 16;
                    f32x4 v0 = acc[ai][bj][m][0], v1 = acc[ai][bj][m][1];
                    if (kind) { const float* cs = (kind == 1 ? csq + (size_t)row * 64 : csi + (size_t)row * 16) + pb * 2;
                        const f32x4 c01 = *(const f32x4*)cs, c23 = *(const f32x4*)(cs + 4);
                        f32x4 r0, r1;
                        r0[0] = v0[0] * c01[0] - v0[1] * c01[1]; r0[1] = v0[1] * c01[0] + v0[0] * c01[1];
                        r0[2] = v0[2] * c01[2] - v0[3] * c01[3]; r0[3] = v0[3] * c01[2] + v0[2] * c01[3];
                        r1[0] = v1[0] * c23[0] - v1[1] * c23[1]; r1[1] = v1[1] * c23[0] + v1[0] * c23[1];
                        r1[2] = v1[2] * c23[2] - v1[3] * c23[3]; r1[3] = v1[3] * c23[2] + v1[2] * c23[3];
                        v0 = r0; v1 = r1; }
                    if (f32out) { float* o = WI + (size_t)row * 16 + dcol; *(f32x4*)o = v0 * wscale; *(f32x4*)(o + 4) = v1 * wscale; }
                    else { u32x4 w; w.x = cvt_pk_bf16(v0[0], v0[1]); w.y = cvt_pk_bf16(v0[2], v0[3]); w.z = cvt_pk_bf16(v1[0], v1[1]); w.w = cvt_pk_bf16(v1[2], v1[3]);
                        *(u32x4*)(dst + (size_t)row * ld + dcol) = w; }
                    asm volatile("" ::: "memory"); }
        }
    }
};
}
constexpr int NWAVES = 8;
constexpr int BATCH = 2, SEQ = 8192, DM = 1024, M = BATCH * SEQ;
constexpr int FF = 2816, FF2 = 2 * FF, NQKV0 = 3072, N1PAD = 5632, W_IN_AB = 3080, W_IN_C = 5456;
constexpr float LN_EPS = 1e-5f, ALPHA = 1.4142135623730951f;
constexpr float IDX_SCALE = 0.03125f, DSA_SCALE = 0.0625f;
constexpr int NIN = 24;
constexpr size_t MiB = 1u << 20;
constexpr size_t WS_CTL = 0, CTL_ZERO_BYTES = 64 * 1024;
constexpr size_t WS_LSF = 1 * MiB, WS_CUM = WS_LSF + 512 * 1024;
constexpr size_t WS_XB = 2 * MiB;
constexpr size_t WS_W0IN = 34 * MiB, WS_W0O = 40 * MiB, WS_W0UP = 42 * MiB, WS_W0DN = 53 * MiB;
constexpr size_t WS_W1IN = 34 * MiB, WS_WC = 45 * MiB, WS_CSQ = 51 * MiB, WS_CSI = 55 * MiB, WS_WI = 56 * MiB, WS_KI = 57 * MiB;
constexpr size_t WS_BIG = 59 * MiB;
constexpr size_t WS_QO = WS_BIG, WS_K = WS_QO + 32 * MiB, WS_V = WS_K + 32 * MiB;
constexpr size_t WS_H = WS_BIG;
constexpr size_t WS_QD = WS_BIG, WS_QI = WS_QD + 128 * MiB, WS_KL = WS_QI + 32 * MiB, WS_IDX = WS_KL + 8 * MiB;
constexpr size_t WS_W1UP = 235 * MiB, WS_W1DN = 246 * MiB, WS_END = 256 * MiB;
static_assert(WS_H + (size_t)M * FF2 * 2 <= WS_W1UP && WS_IDX + (size_t)M * 256 * 2 <= WS_W1UP && WS_W1DN + (size_t)DM * FF * 2 <= WS_END && WS_W0DN + (size_t)DM * FF * 2 <= WS_BIG && WS_KI + (size_t)M * 64 * 2 <= WS_BIG, "d_ws map");
constexpr int CW_TMO = 0, CW_CODE = 1, CW_KN = 64, CW_BAR = 4096;
constexpr int RING_OFF = 0, RING_BYTES = 131072;
constexpr int LDSCTL_OFF = RING_BYTES, MISC_OFF = LDSCTL_OFF + 320;
constexpr int LDS_BYTES = 147456;
#define GAS __attribute__((address_space(1)))
#define LAS __attribute__((address_space(3)))
typedef unsigned short bf16;
typedef unsigned v4u __attribute__((ext_vector_type(4)));
typedef float f32x4 __attribute__((ext_vector_type(4)));
typedef short bf16x8 __attribute__((ext_vector_type(8)));
typedef GAS unsigned gu32;
typedef GAS unsigned long long gu64;
#define RLX_AGENT __ATOMIC_RELAXED, __HIP_MEMORY_SCOPE_AGENT
#define LDS_WAIT() asm volatile("s_waitcnt lgkmcnt(0)" ::: "memory")
#define VM_WAIT() asm volatile("s_waitcnt vmcnt(0)" ::: "memory")
__device__ __forceinline__ unsigned long long rt() { return __builtin_amdgcn_s_memrealtime(); }
__device__ __forceinline__ unsigned f2bf(float f) { unsigned u = __builtin_bit_cast(unsigned, f); return (u + 0x7fffu + ((u >> 16) & 1u)) >> 16; }
__device__ __forceinline__ unsigned pk2(float lo, float hi) { return f2bf(lo) | (f2bf(hi) << 16); }

#define XB_TMO      128
#define XB_XCNT(j)  (256  + 64 * (j))
#define XB_XSUB(j)  (1280 + 64 * (j))
#define XB_XGEN(j)  (2304 + 64 * (j))
#define XB_TOP      3328
#define XB_TOPGEN   3392
#define XCD_BAR_WORDS 3456
#define XB_SPIN_CAP (1u << 18)

__device__ __forceinline__ unsigned xb_ld(unsigned* p)              { return __hip_atomic_load(p, __ATOMIC_RELAXED, __HIP_MEMORY_SCOPE_AGENT); }
__device__ __forceinline__ unsigned xb_add(unsigned* p, unsigned v) { return __hip_atomic_fetch_add(p, v, __ATOMIC_RELAXED, __HIP_MEMORY_SCOPE_AGENT); }
__device__ __forceinline__ unsigned xb_xcc_id() { return (unsigned)__builtin_amdgcn_s_getreg((3 << 11) | 20) & 0xFu; }
#define XB_SPIN(cond, bar) do { unsigned _sp = 0; while (cond) { __builtin_amdgcn_s_sleep(1); \
    if ((++_sp & 255u) == 0u) { if (xb_ld(&(bar)[XB_TMO])) break; if (_sp > XB_SPIN_CAP) { atomicAdd(&(bar)[XB_TMO], 1u); break; } } } } while (0)

struct XcdBarrier {
    unsigned* bar; unsigned x;
    volatile LAS unsigned* st;
};

__device__ __forceinline__ XcdBarrier xcd_barrier_post(unsigned* bar, volatile LAS unsigned* st) {
    XcdBarrier b; b.bar = bar; b.x = xb_xcc_id(); b.st = st;
    if (threadIdx.x == 0) (void)xb_add(&bar[XB_XCNT(b.x)], 1u);
    return b;
}
__device__ __forceinline__ void xcd_barrier_complete(unsigned* bar, unsigned x, unsigned& nloc, unsigned& nx) {
    const unsigned G = gridDim.x * gridDim.y * gridDim.z;
    unsigned sum, cnt, mine, sp = 0u;
    for (;;) {
        sum = 0u; cnt = 0u; mine = 0u;
#pragma unroll
        for (unsigned j = 0; j < 16; ++j) { const unsigned c = xb_ld(&bar[XB_XCNT(j)]); sum += c; cnt += (c > 0u) ? 1u : 0u; mine = (j == x) ? c : mine; }
        if (sum == G) break;
        __builtin_amdgcn_s_sleep(1);
        if ((++sp & 255u) == 0u) { if (xb_ld(&bar[XB_TMO])) break; if (sp > XB_SPIN_CAP) { atomicAdd(&bar[XB_TMO], 1u); break; } }
    }
    nloc = mine > 0u ? mine : 1u; nx = cnt > 0u ? cnt : 1u;
}

__device__ __forceinline__ void xcd_barrier(const XcdBarrier& b) {
    asm volatile("s_waitcnt vmcnt(0)" ::: "memory");
    __syncthreads();
    if (threadIdx.x == 0) {
        unsigned* bar = b.bar;
        __builtin_amdgcn_s_waitcnt(0);
        unsigned nloc = b.st[0], nx = b.st[1];
        if (nloc == 0u) { xcd_barrier_complete(bar, b.x, nloc, nx); b.st[0] = nloc; b.st[1] = nx; }
        const unsigned old = xb_add(&bar[XB_XSUB(b.x)], 1u);
        const unsigned gen = old / nloc;
        if (old + 1u == (gen + 1u) * nloc) {
            __builtin_amdgcn_fence(__ATOMIC_RELEASE, "agent");
            asm volatile("s_waitcnt vmcnt(0)" ::: "memory");
            const unsigned og = xb_add(&bar[XB_TOP], 1u);
            const unsigned tg = og / nx;
            if (og + 1u == (tg + 1u) * nx) xb_add(&bar[XB_TOPGEN], 1u);
            else XB_SPIN(xb_ld(&bar[XB_TOPGEN]) == tg, bar);
            __builtin_amdgcn_fence(__ATOMIC_ACQUIRE, "agent");
            xb_add(&bar[XB_XGEN(b.x)], 1u);
            asm volatile("s_waitcnt vmcnt(0)" ::: "memory");
        } else {
            XB_SPIN(xb_ld(&bar[XB_XGEN(b.x)]) == gen, bar);
            __builtin_amdgcn_fence(__ATOMIC_ACQUIRE, "agent");
            asm volatile("s_waitcnt vmcnt(0)" ::: "memory");
        }
    }
    __syncthreads();
}

typedef float f32x16 __attribute__((ext_vector_type(16)));
typedef unsigned v2u __attribute__((ext_vector_type(2)));
typedef short s16x4 __attribute__((ext_vector_type(4)));
typedef unsigned short u16;
struct Args { const float* in[NIN]; float* out; unsigned char* ws; };
struct Frame {
    LAS unsigned char* lds; volatile LAS unsigned* MISC; gu32* ctl;
    int tid, lane, wave, G, vcu;
    unsigned char* ws; float* out;
};
__device__ __forceinline__ float wave_sum(float v) {
#pragma unroll
    for (int o = 1; o < 64; o <<= 1) v += __shfl_xor(v, o);
    return v;
}
__device__ __forceinline__ float bf2f(unsigned short b) { return __uint_as_float((unsigned)b << 16); }
__device__ __forceinline__ float bflo(unsigned w) { return __uint_as_float(w << 16); }
__device__ __forceinline__ float bfhi(unsigned w) { return __uint_as_float(w & 0xffff0000u); }
__device__ __forceinline__ unsigned cvtpk(float lo, float hi) { unsigned r; asm volatile("v_cvt_pk_bf16_f32 %0, %1, %2" : "=v"(r) : "v"(lo), "v"(hi)); return r; }

template <class CM> __device__ __forceinline__ void tr_item(const float* __restrict__ W, int K, int Nsrc, bf16* WT, int nblk, int item, LAS float* scr, int lane, const CM& colmap) {
    const int kb = item / nblk, nb = item % nblk, k0 = 64 * kb, n0 = 32 * nb;
    const int sc = colmap(n0 + (lane & 31));
#pragma unroll 8
    for (int i = 0; i < 32; ++i) { const int kk = 2 * i + (lane >> 5); scr[kk * 33 + (lane & 31)] = sc >= 0 ? W[(size_t)(k0 + kk) * Nsrc + sc] : 0.f; }
    LDS_WAIT(); asm volatile("" ::: "memory");
    const int c = lane & 7;
#pragma unroll
    for (int j = 0; j < 4; ++j) { const int n = (lane >> 3) + 8 * j; const LAS float* s = scr + (8 * c) * 33 + n;
        v4u o; o.x = pk2(s[0 * 33], s[1 * 33]); o.y = pk2(s[2 * 33], s[3 * 33]); o.z = pk2(s[4 * 33], s[5 * 33]); o.w = pk2(s[6 * 33], s[7 * 33]);
        *(GAS v4u*)(WT + (size_t)(n0 + n) * K + k0 + 8 * c) = o; }
    LDS_WAIT(); asm volatile("" ::: "memory");
}
struct CmIdent { __device__ __forceinline__ int operator()(int n) const { return n; } };
struct CmL0In { __device__ __forceinline__ int operator()(int n) const { const int blk = n >> 9, j = n & 511; const int sb = (blk & 1) * 3 + (blk >> 1); return sb * 512 + j; } };
struct CmL1In { __device__ __forceinline__ int operator()(int n) const {
    if (n < 4096 + 256) { const int j = n & 255, base = n - j; return base + (j < 64 ? (j >> 1) + 32 * (j & 1) : j); }
    if (n < 5376 + 64) { const int jj = n - 4352, j = jj & 63, base = 4352 + (jj - j); return base + (j < 16 ? (j >> 1) + 8 * (j & 1) : j); }
    if (n < 5376 + 80) return 5440 + (n - 5440);
    return -1; } };

__device__ __forceinline__ void p0_row(const float* xrow, bf16* orow, float* lsf, const LAS float* wf, const float* bfv, int lane) {
    const GAS f32x4* xr = (const GAS f32x4*)xrow + lane;
    f32x4 v[4];
#pragma unroll
    for (int j = 0; j < 4; ++j) v[j] = xr[64 * j];
    GAS unsigned long long* o8 = (GAS unsigned long long*)orow + lane;
#pragma unroll
    for (int j = 0; j < 4; ++j) o8[64 * j] = (unsigned long long)pk2(v[j].x, v[j].y) | ((unsigned long long)pk2(v[j].z, v[j].w) << 32);
    float a[8] = {0.f, 0.f, 0.f, 0.f, 0.f, 0.f, 0.f, 0.f};
#pragma unroll
    for (int j = 0; j < 4; ++j)
#pragma unroll
        for (int e = 0; e < 4; ++e) { const int k = 256 * j + 4 * lane + e; const f32x4 w0 = *(const LAS f32x4*)(wf + k * 8), w1 = *(const LAS f32x4*)(wf + k * 8 + 4); const float xv = v[j][e];
            a[0] += xv * w0[0]; a[1] += xv * w0[1]; a[2] += xv * w0[2]; a[3] += xv * w0[3]; a[4] += xv * w1[0]; a[5] += xv * w1[1]; a[6] += xv * w1[2]; a[7] += xv * w1[3]; }
#pragma unroll
    for (int h = 0; h < 8; ++h) a[h] = wave_sum(a[h]);
    float mine = a[0];
#pragma unroll
    for (int h = 1; h < 8; ++h) mine = (lane == h) ? a[h] : mine;
    if (lane < 8) { const float f = mine + bfv[lane]; const float ls = -(fmaxf(-f, 0.f) + log1pf(__expf(-fabsf(f)))); lsf[lane] = ls; }
}
__device__ __forceinline__ void p0_prologue(Frame& F, const Args& A) {
    LAS float* scr = (LAS float*)(F.lds + RING_OFF + F.wave * 8704);
    LAS float* wf = (LAS float*)(F.lds + RING_OFF + 73728);
    const float* w0in = A.in[2];
    for (int i = F.tid; i < 1024 * 8; i += NWAVES * 64) wf[i] = w0in[(size_t)(i >> 3) * W_IN_AB + 3072 + (i & 7)];
    __syncthreads();
    const int gw = F.vcu * NWAVES + F.wave, NGW = F.G * NWAVES;
    constexpr int I_IN = 16 * (NQKV0 / 32), I_O = 16 * 32, I_UP = 16 * (FF2 / 32), I_DN = (FF / 64) * 32;
    constexpr int NITEMS = I_IN + I_O + 2 * I_UP + 2 * I_DN;
    bf16* ws16 = (bf16*)F.ws;
    for (int it = gw; it < NITEMS; it += NGW) {
        int r = it;
        if (r < I_IN) { tr_item(A.in[2], DM, W_IN_AB, (bf16*)(F.ws + WS_W0IN), NQKV0 / 32, r, scr, F.lane, CmL0In()); continue; } r -= I_IN;
        if (r < I_O) { tr_item(A.in[4], DM, DM, (bf16*)(F.ws + WS_W0O), 32, r, scr, F.lane, CmIdent()); continue; } r -= I_O;
        if (r < I_UP) { tr_item(A.in[7], DM, FF2, (bf16*)(F.ws + WS_W0UP), FF2 / 32, r, scr, F.lane, CmIdent()); continue; } r -= I_UP;
        if (r < I_DN) { tr_item(A.in[10], FF, DM, (bf16*)(F.ws + WS_W0DN), 32, r, scr, F.lane, CmIdent()); continue; } r -= I_DN;
        if (r < I_UP) { tr_item(A.in[18], DM, FF2, (bf16*)(F.ws + WS_W1UP), FF2 / 32, r, scr, F.lane, CmIdent()); continue; } r -= I_UP;
        tr_item(A.in[21], FF, DM, (bf16*)(F.ws + WS_W1DN), 32, r, scr, F.lane, CmIdent());
    }
    (void)ws16;
    const float* x = A.in[0]; bf16* XB = (bf16*)(F.ws + WS_XB); float* LSF = (float*)(F.ws + WS_LSF);
    for (int m = gw; m < M; m += NGW) p0_row(x + (size_t)m * DM, XB + (size_t)m * DM, LSF + (size_t)m * 8, wf, A.in[3], F.lane);
}

__device__ __forceinline__ void p1b_scan_kn(Frame& F) {
    const float* LSF = (const float*)(F.ws + WS_LSF); float* CUM = (float*)(F.ws + WS_CUM);
    if (blockIdx.x < 16) {
        const int b = blockIdx.x >> 3, h = blockIdx.x & 7, t0 = 16 * F.tid;
        float v[16]; float s = 0.f;
#pragma unroll
        for (int j = 0; j < 16; ++j) { s += LSF[(size_t)(b * SEQ + t0 + j) * 8 + h]; v[j] = s; }
        float inc = s;
#pragma unroll
        for (int o = 1; o < 64; o <<= 1) { const float u = __shfl_up(inc, o); if (F.lane >= o) inc += u; }
        LAS float* wt = (LAS float*)(F.lds + RING_OFF);
        if (F.lane == 63) wt[F.wave] = inc;
        __syncthreads();
        float off = inc - s;
        for (int w = 0; w < F.wave; ++w) off += wt[w];
#pragma unroll
        for (int j = 0; j < 16; ++j) CUM[(size_t)(b * 8 + h) * SEQ + t0 + j] = off + v[j];
        __syncthreads();
    } else {
        const bf16* KB = (const bf16*)(F.ws + WS_K);
        const int gw = (blockIdx.x - 16) * NWAVES + F.wave, NGW = (F.G - 16) * NWAVES;
        float mx0 = 0.f, mx1 = 0.f;
        for (int m = gw; m < M; m += NGW) {
            const v4u w = *(const GAS v4u*)(KB + (size_t)m * DM + 512 + F.lane * 8);
            float s = bflo(w.x) * bflo(w.x) + bfhi(w.x) * bfhi(w.x) + bflo(w.y) * bflo(w.y) + bfhi(w.y) * bfhi(w.y) + bflo(w.z) * bflo(w.z) + bfhi(w.z) * bfhi(w.z) + bflo(w.w) * bflo(w.w) + bfhi(w.w) * bfhi(w.w);
            s += __shfl_xor(s, 1); s += __shfl_xor(s, 2); s += __shfl_xor(s, 4);
            if (m < SEQ) mx0 = fmaxf(mx0, s); else mx1 = fmaxf(mx1, s);
        }
        if ((F.lane & 7) == 0) { atomicMax((unsigned*)(F.ctl + CW_KN) + (F.lane >> 3), __float_as_uint(mx0)); atomicMax((unsigned*)(F.ctl + CW_KN) + 8 + (F.lane >> 3), __float_as_uint(mx1)); }
    }
}
__device__ __forceinline__ void ln_phase(Frame& F, float* y, const float* g, const float* bta, bf16* xb) {
    const int gw = F.vcu * NWAVES + F.wave, NGW = F.G * NWAVES;
    f32x4 gv[4], bv[4];
#pragma unroll
    for (int j = 0; j < 4; ++j) { gv[j] = ((const GAS f32x4*)g)[F.lane + 64 * j]; bv[j] = ((const GAS f32x4*)bta)[F.lane + 64 * j]; }
    for (int m = gw; m < M; m += NGW) {
        GAS f32x4* yr = (GAS f32x4*)(y + (size_t)m * DM) + F.lane;
        f32x4 v[4]; float s = 0.f;
#pragma unroll
        for (int j = 0; j < 4; ++j) { v[j] = yr[64 * j]; s += (v[j].x + v[j].y) + (v[j].z + v[j].w); }
        const float mean = wave_sum(s) * (1.f / DM); float s2 = 0.f;
#pragma unroll
        for (int j = 0; j < 4; ++j) { v[j] = v[j] - mean; s2 += (v[j].x * v[j].x + v[j].y * v[j].y) + (v[j].z * v[j].z + v[j].w * v[j].w); }
        const float rstd = 1.f / sqrtf(wave_sum(s2) * (1.f / DM) + LN_EPS);
#pragma unroll
        for (int j = 0; j < 4; ++j) { v[j] = v[j] * rstd * gv[j] + bv[j]; yr[64 * j] = v[j]; }
        if (xb) { GAS unsigned long long* o8 = (GAS unsigned long long*)(xb + (size_t)m * DM) + F.lane;
#pragma unroll
            for (int j = 0; j < 4; ++j) o8[64 * j] = (unsigned long long)pk2(v[j].x, v[j].y) | ((unsigned long long)pk2(v[j].z, v[j].w) << 32); }
    }
}
__device__ __forceinline__ float gelu_tanh(float x) { const float u = 0.7978845608028654f * (x + 0.044715f * x * x * x); return x / (1.f + __expf(-2.f * u)); }
__device__ __forceinline__ void conv_phase(Frame& F, bf16* H, const float* cw, const float* cb) {
    constexpr int NCG = FF / 8, NRUN = M / 16;
    const int gt = F.vcu * (NWAVES * 64) + F.tid, NGT = F.G * NWAVES * 64;
    for (int it = gt; it < NCG * NRUN; it += NGT) {
        const int cg = it % NCG, run = it / NCG, c0 = cg * 8, row0 = run * 16;
        float w0[8], w1[8], w2[8], b0[8];
#pragma unroll
        for (int e = 0; e < 8; ++e) { w0[e] = cw[c0 + e]; w1[e] = cw[FF + c0 + e]; w2[e] = cw[2 * FF + c0 + e]; b0[e] = cb[c0 + e]; }
        v4u g2 = (v4u){0u, 0u, 0u, 0u}, g1 = g2;
        if ((row0 & (SEQ - 1)) != 0) { g2 = *(const GAS v4u*)(H + (size_t)(row0 - 2) * FF2 + c0); g1 = *(const GAS v4u*)(H + (size_t)(row0 - 1) * FF2 + c0); }
        for (int j = 0; j < 16; ++j) {
            const size_t off = (size_t)(row0 + j) * FF2 + c0;
            const v4u g0 = *(const GAS v4u*)(H + off), uu = *(const GAS v4u*)(H + off + FF);
            unsigned gg2[4] = {g2.x, g2.y, g2.z, g2.w}, gg1[4] = {g1.x, g1.y, g1.z, g1.w}, gg0[4] = {g0.x, g0.y, g0.z, g0.w}, u4[4] = {uu.x, uu.y, uu.z, uu.w}, o[4];
#pragma unroll
            for (int p = 0; p < 4; ++p) {
                const float ca = b0[2 * p] + w0[2 * p] * bflo(gg2[p]) + w1[2 * p] * bflo(gg1[p]) + w2[2 * p] * bflo(gg0[p]);
                const float cb2 = b0[2 * p + 1] + w0[2 * p + 1] * bfhi(gg2[p]) + w1[2 * p + 1] * bfhi(gg1[p]) + w2[2 * p + 1] * bfhi(gg0[p]);
                o[p] = pk2(gelu_tanh(ca) * bflo(u4[p]), gelu_tanh(cb2) * bfhi(u4[p]));
            }
            *(GAS v4u*)(H + off + FF) = (v4u){o[0], o[1], o[2], o[3]};
            g2 = g1; g1 = g0;
        }
    }
}
__device__ __forceinline__ void p8_prep(Frame& F, const Args& A) {
    LAS float* scr = (LAS float*)(F.lds + RING_OFF + F.wave * 8704);
    const int gw = F.vcu * NWAVES + F.wave, NGW = F.G * NWAVES;
    constexpr int I_IN1 = 16 * (N1PAD / 32);
    for (int it = gw; it < I_IN1; it += NGW) tr_item(A.in[13], DM, W_IN_C, (bf16*)(F.ws + WS_W1IN), N1PAD / 32, it, scr, F.lane, CmL1In());
    const int gt = F.vcu * (NWAVES * 64) + F.tid, NGT = F.G * NWAVES * 64;
    const float* wuv = A.in[14]; const float* wo = A.in[15]; bf16* WcT = (bf16*)(F.ws + WS_WC);
    for (int it = gt; it < 1024 * 384; it += NGT) {
        const int n = it & 1023, hcg = it >> 10, h = hcg / 24, c0 = (hcg % 24) * 8;
        float a[8] = {0.f, 0.f, 0.f, 0.f, 0.f, 0.f, 0.f, 0.f};
        for (int d = 0; d < 64; ++d) { const float w = wo[(size_t)(h * 64 + d) * DM + n];
#pragma unroll
            for (int e = 0; e < 8; ++e) a[e] += wuv[(size_t)(h * 192 + c0 + e) * 64 + d] * w; }
        *(GAS v4u*)(WcT + (size_t)n * 3072 + h * 192 + c0) = (v4u){pk2(a[0], a[1]), pk2(a[2], a[3]), pk2(a[4], a[5]), pk2(a[6], a[7])};
    }
    const int* pos = (const int*)A.in[1]; float* csq = (float*)(F.ws + WS_CSQ); float* csi = (float*)(F.ws + WS_CSI);
    for (int it = gt; it < M * 40; it += NGT) {
        const int row = it / 40, i = it % 40;
        double fq = 1.0; { const double rr = i < 32 ? 0.6636012376960885 : 0.19392274474868576; const int ii = i < 32 ? i : i - 32; for (int q = 0; q < ii; ++q) fq *= rr; }
        const float ang = (float)pos[row] * (float)fq;
        double rev = (double)ang * 0.15915494309189535; rev -= __builtin_rint(rev);
        const float fr = (float)rev, c = __builtin_amdgcn_cosf(fr), s = __builtin_amdgcn_sinf(fr);
        float* dst = i < 32 ? csq + (size_t)row * 64 + 2 * i : csi + (size_t)row * 16 + 2 * (i - 32);
        dst[0] = c; dst[1] = s;
    }
}
constexpr int A0_K = 0, A0_V = 16384, A0_CK = 32768, A0_FLAG = 33280, A0_WS = 33344;
__device__ __forceinline__ int crow(int r, int hi) { return (r & 3) + 8 * (r >> 2) + 4 * hi; }
__device__ __forceinline__ s16x4 vtr(const LAS unsigned char* p) { return __builtin_bit_cast(s16x4, __builtin_amdgcn_ds_read_tr16_b64_v4i16((LAS s16x4*)p)); }
__device__ __forceinline__ void sb_sub(f32x16& p, int kbase, int tq, int hi, bool needmask, float& R) {
    float ls[16];
#pragma unroll
    for (int r = 0; r < 16; ++r) { const float z = p[r], e = __expf(-fabsf(z)), sp = fmaxf(z, 0.f) + __logf(1.f + e); const bool vis = !needmask || (kbase + crow(r, hi) < tq);
        ls[r] = vis ? -sp : 0.f; p[r] = vis ? (z - sp) : -INFINITY; }
    float T[4], Tp[4];
#pragma unroll
    for (int g = 0; g < 4; ++g) { T[g] = (ls[4 * g] + ls[4 * g + 1]) + (ls[4 * g + 2] + ls[4 * g + 3]); Tp[g] = __shfl_xor(T[g], 32); }
    float E = 0.f;
#pragma unroll
    for (int g = 3; g >= 0; --g) {
        const float a3 = R + E + (hi == 0 ? Tp[g] : 0.f), a2 = a3 + ls[4 * g + 3], a1 = a2 + ls[4 * g + 2], a0 = a1 + ls[4 * g + 1];
        p[4 * g + 3] = __expf(p[4 * g + 3] + a3); p[4 * g + 2] = __expf(p[4 * g + 2] + a2); p[4 * g + 1] = __expf(p[4 * g + 1] + a1); p[4 * g] = __expf(p[4 * g] + a0);
        E += T[g] + Tp[g];
    }
    R += E;
}
template <bool FOX> __device__ __forceinline__ void attn0_unit(Frame& F, int b, int h, int qb) {
    LAS unsigned char* L = F.lds + RING_OFF;
    const int tid = F.tid, lane = F.lane, wave = F.wave, r32 = lane & 31, hi = lane >> 5;
    const bf16* Qg = (const bf16*)(F.ws + WS_QO); const bf16* Kg = (const bf16*)(F.ws + WS_K); const bf16* Vg = (const bf16*)(F.ws + WS_V); bf16* Og = (bf16*)(F.ws + WS_QO);
    const float* CUM = (const float*)(F.ws + WS_CUM) + (size_t)(b * 8 + (h & 7)) * SEQ;
    const size_t rowbase = (size_t)b * SEQ; const int q0 = qb * 256, qmin = q0 + wave * 32, qmax = qmin + 31, tq = qmin + r32;
    bf16x8 qf[4];
#pragma unroll
    for (int ks = 0; ks < 4; ++ks) qf[ks] = *(const GAS bf16x8*)(Qg + (rowbase + tq) * DM + h * 64 + 16 * ks + 8 * hi);
    float cq = 0.f, qn = 0.f, knmax = 0.f;
    if (FOX) { cq = CUM[tq]; float s = 0.f;
#pragma unroll
        for (int ks = 0; ks < 4; ++ks)
#pragma unroll
            for (int j = 0; j < 8; ++j) { const float v = bf2f((unsigned short)qf[ks][j]); s += v * v; }
        s += __shfl_xor(s, 32); qn = sqrtf(s); knmax = sqrtf(__uint_as_float(__hip_atomic_load(F.ctl + CW_KN + b * 8 + (h & 7), RLX_AGENT))); }
    f32x16 o0, o1;
#pragma unroll
    for (int r = 0; r < 16; ++r) { o0[r] = 0.f; o1[r] = 0.f; }
    float mrun = -INFINITY, lrun = 0.f, R = 0.f; bool wdone = false;
    const int kt_hi = qb * 4 + 3;
    const int skey = tid >> 3, sch = tid & 7;
    const size_t goff = (rowbase + skey) * DM + h * 64 + sch * 8;
    const int kdst = A0_K + skey * 128 + ((sch ^ (skey & 7)) * 16);
    const int vdst = A0_V + skey * 128 + (((sch >> 2) ^ ((skey >> 1) & 1)) * 64) + (sch & 3) * 16;
    LAS float* wsf = (LAS float*)(L + A0_WS) + wave * 32;
    {   const v4u kreg = *(const GAS v4u*)(Kg + goff + (size_t)kt_hi * 64 * DM), vreg = *(const GAS v4u*)(Vg + goff + (size_t)kt_hi * 64 * DM);
        *(LAS v4u*)(L + kdst) = kreg; *(LAS v4u*)(L + vdst) = vreg;
        if (FOX && tid < 64) ((LAS float*)(L + A0_CK))[tid] = CUM[kt_hi * 64 + tid]; }
    __syncthreads();
    int buf = 0;
    for (int kt = kt_hi; ; --kt) {
        const bool more = kt > 0; const int k0 = kt * 64;
        v4u kreg = (v4u){0u, 0u, 0u, 0u}, vreg = kreg; float ckreg = 0.f;
        if (more) { kreg = *(const GAS v4u*)(Kg + goff + (size_t)(kt - 1) * 64 * DM); vreg = *(const GAS v4u*)(Vg + goff + (size_t)(kt - 1) * 64 * DM); if (FOX && tid < 64) ckreg = CUM[(kt - 1) * 64 + tid]; }
        const bool active = !wdone && (k0 <= qmax);
        if (active) {
            const bool needmask = (k0 + 63 >= qmin);
            const LAS unsigned char* Kb = L + A0_K + buf * 8192; const LAS unsigned char* Vb = L + A0_V + buf * 8192;
            f32x16 p0, p1;
#pragma unroll
            for (int r = 0; r < 16; ++r) { p0[r] = 0.f; p1[r] = 0.f; }
#pragma unroll
            for (int ks = 0; ks < 4; ++ks) { const int ch = ((2 * ks + hi) ^ (r32 & 7)) * 16;
                const bf16x8 a0 = *(const LAS bf16x8*)(Kb + r32 * 128 + ch), a1 = *(const LAS bf16x8*)(Kb + (32 + r32) * 128 + ch);
                p0 = __builtin_amdgcn_mfma_f32_32x32x16_bf16(a0, qf[ks], p0, 0, 0, 0); p1 = __builtin_amdgcn_mfma_f32_32x32x16_bf16(a1, qf[ks], p1, 0, 0, 0); }
            if (FOX) {
                const LAS float* ckb = (const LAS float*)(L + A0_CK) + buf * 64;
#pragma unroll
                for (int g = 0; g < 4; ++g) { const f32x4 c0v = *(const LAS f32x4*)(ckb + 8 * g + 4 * hi), c1v = *(const LAS f32x4*)(ckb + 32 + 8 * g + 4 * hi);
#pragma unroll
                    for (int i = 0; i < 4; ++i) { p0[4 * g + i] += cq - c0v[i]; p1[4 * g + i] += cq - c1v[i]; } }
                if (needmask) {
#pragma unroll
                    for (int r = 0; r < 16; ++r) { const int key = k0 + crow(r, hi); if (key > tq) p0[r] = -INFINITY; if (key + 32 > tq) p1[r] = -INFINITY; } }
                float rm = fmaxf(p0[0], p1[0]);
#pragma unroll
                for (int r = 1; r < 16; ++r) rm = fmaxf(rm, fmaxf(p0[r], p1[r]));
                rm = fmaxf(rm, __shfl_xor(rm, 32));
                const float mnew = fmaxf(mrun, rm), alpha = __expf(mrun - mnew);
                float ps = 0.f;
#pragma unroll
                for (int r = 0; r < 16; ++r) { p0[r] = __expf(p0[r] - mnew); p1[r] = __expf(p1[r] - mnew); ps += p0[r] + p1[r]; }
                lrun = lrun * alpha + ps; mrun = mnew;
                if (__any(alpha != 1.f)) {
                    if (hi == 0) wsf[r32] = alpha;
                    __builtin_amdgcn_wave_barrier();
#pragma unroll
                    for (int r = 0; r < 16; ++r) { const float f = wsf[crow(r, hi)]; o0[r] *= f; o1[r] *= f; }
                    __builtin_amdgcn_wave_barrier();
                }
            } else {
                sb_sub(p1, k0 + 32, tq, hi, needmask, R);
                sb_sub(p0, k0, tq, hi, needmask, R);
            }
            const int vlane = ((lane >> 4) & 1) * 32 + (lane & 3) * 8, kq = 4 * hi + ((lane & 15) >> 2);
#pragma unroll
            for (int sub = 0; sub < 2; ++sub)
#pragma unroll
                for (int s = 0; s < 2; ++s) {
                    v4u pw;
                    if (sub == 0) { pw.x = cvtpk(p0[8 * s], p0[8 * s + 1]); pw.y = cvtpk(p0[8 * s + 2], p0[8 * s + 3]); pw.z = cvtpk(p0[8 * s + 4], p0[8 * s + 5]); pw.w = cvtpk(p0[8 * s + 6], p0[8 * s + 7]); }
                    else { pw.x = cvtpk(p1[8 * s], p1[8 * s + 1]); pw.y = cvtpk(p1[8 * s + 2], p1[8 * s + 3]); pw.z = cvtpk(p1[8 * s + 4], p1[8 * s + 5]); pw.w = cvtpk(p1[8 * s + 6], p1[8 * s + 7]); }
                    const bf16x8 pa = __builtin_bit_cast(bf16x8, pw);
                    const int key0 = 32 * sub + 16 * s + kq, sw = (key0 >> 1) & 1;
#pragma unroll
                    for (int db = 0; db < 2; ++db) {
                        const LAS unsigned char* va = Vb + key0 * 128 + ((db ^ sw) * 64) + vlane;
                        const s16x4 lo = vtr(va), hh = vtr(va + 8 * 128);
                        const bf16x8 vf = (bf16x8){lo[0], lo[1], lo[2], lo[3], hh[0], hh[1], hh[2], hh[3]};
                        if (db == 0) o0 = __builtin_amdgcn_mfma_f32_32x32x16_bf16(pa, vf, o0, 0, 0, 0); else o1 = __builtin_amdgcn_mfma_f32_32x32x16_bf16(pa, vf, o1, 0, 0, 0);
                    }
                }
        }
        if (!wdone) {
            if (!more) wdone = true;
            else if (FOX) { const float bound = qn * knmax + cq - CUM[k0 - 1]; wdone = __all(bound < mrun - 30.f); }
            else wdone = __all(R < -30.f);
        }
        LAS unsigned* flg = (LAS unsigned*)(L + A0_FLAG) + (kt & 1) * 8;
        if (lane == 0) flg[wave] = wdone ? 1u : 0u;
        if (more) { const int o = (buf ^ 1) * 8192; *(LAS v4u*)(L + kdst + o) = kreg; *(LAS v4u*)(L + vdst + o) = vreg; if (FOX && tid < 64) ((LAS float*)(L + A0_CK))[(buf ^ 1) * 64 + tid] = ckreg; }
        __syncthreads();
        if (!more) break;
        unsigned alld = 1u;
#pragma unroll
        for (int w = 0; w < 8; ++w) alld &= flg[w];
        if (alld) break;
        buf ^= 1;
    }
    float inv = 1.f;
    if (FOX) { const float lt = lrun + __shfl_xor(lrun, 32); inv = 1.f / lt; }
    if (hi == 0) wsf[r32] = inv;
    __builtin_amdgcn_wave_barrier();
#pragma unroll
    for (int r = 0; r < 16; ++r) { const float f = wsf[crow(r, hi)]; bf16* op = Og + (rowbase + qmin + crow(r, hi)) * DM + h * 64 + r32;
        op[0] = (bf16)f2bf(o0[r] * f); op[32] = (bf16)f2bf(o1[r] * f); }
    __syncthreads();
}
__device__ __forceinline__ void p2_attention(Frame& F) {
    for (int u = F.vcu; u < 512; u += F.G) attn0_unit<true>(F, u >> 8, 8 + ((u >> 5) & 7), u & 31);
    for (int u = F.vcu; u < 512; u += F.G) attn0_unit<false>(F, u >> 8, (u >> 5) & 7, u & 31);
}
constexpr int IX_QS = 0, IX_SC = 36864, IX_ID = 86016, IX_HIST = 110592, IX_CNT = 118784, IX_TAU = 118848, IX_CAP = 768;
__device__ __forceinline__ unsigned mono_key(float f) { const unsigned u = __float_as_uint(f); return (u & 0x80000000u) ? ~u : (u | 0x80000000u); }
__device__ __forceinline__ float mono_inv(unsigned k) { return __uint_as_float((k & 0x80000000u) ? (k & 0x7fffffffu) : ~k); }
__device__ __forceinline__ float select256(LAS float* sc, LAS u16* id, int n, LAS unsigned* hist, int lane) {
    unsigned prefix = 0u; int kk = 256;
#pragma unroll 1
    for (int pass = 0; pass < 4; ++pass) {
        const int shift = 24 - 8 * pass;
        *(LAS v4u*)(hist + 4 * lane) = (v4u){0u, 0u, 0u, 0u};
        __builtin_amdgcn_wave_barrier();
        for (int i = lane; i < n; i += 64) { const unsigned key = mono_key(sc[i]); const bool match = pass == 0 || (key >> (shift + 8)) == prefix; if (match) atomicAdd((unsigned*)(hist + ((key >> shift) & 255u)), 1u); }
        __builtin_amdgcn_wave_barrier();
        const v4u c = *(const LAS v4u*)(hist + 4 * lane);
        const int tl = (int)(c.x + c.y + c.z + c.w);
        int suf = tl;
#pragma unroll
        for (int o = 1; o < 64; o <<= 1) { const int u = __shfl_down(suf, o); if (lane + o < 64) suf += u; }
        const int exc = suf - tl;
        const bool here = (exc < kk) && (kk <= suf);
        int bin = 0, above = 0;
        if (here) { int run = exc;
            if (run + (int)c.w >= kk) { bin = 4 * lane + 3; above = run; } else { run += (int)c.w;
            if (run + (int)c.z >= kk) { bin = 4 * lane + 2; above = run; } else { run += (int)c.z;
            if (run + (int)c.y >= kk) { bin = 4 * lane + 1; above = run; } else { run += (int)c.y; bin = 4 * lane; above = run; } } } }
        const unsigned long long bm = __ballot(here);
        const int src = (int)__builtin_ctzll(bm | (1ull << 63));
        bin = __shfl(bin, src); above = __shfl(above, src);
        kk -= above; prefix = (prefix << 8) | (unsigned)bin;
    }
    int wpos = 0, eqk = 0;
    const unsigned long long ltmask = (1ull << lane) - 1ull;
    for (int base = 0; base < n; base += 64) {
        const int i = base + lane; const bool valid = i < n;
        const float s = valid ? sc[i] : 0.f; const u16 d = valid ? id[i] : (u16)0; const unsigned key = mono_key(s);
        const bool gt = valid && key > prefix, eq = valid && key == prefix;
        const unsigned long long em = __ballot(eq);
        const bool keep = gt || (eq && (eqk + __popcll(em & ltmask) < kk));
        const unsigned long long km = __ballot(keep);
        const int pos = wpos + __popcll(km & ltmask);
        __builtin_amdgcn_wave_barrier();
        if (keep) { sc[pos] = s; id[pos] = d; }
        __builtin_amdgcn_wave_barrier();
        wpos += __popcll(km); eqk += __popcll(em);
    }
    return mono_inv(prefix);
}
__device__ __forceinline__ void idx_unit(Frame& F, int b, int qg) {
    LAS unsigned char* L = F.lds + RING_OFF;
    const int tid = F.tid, lane = F.lane, wave = F.wave, r32 = lane & 31, hi = lane >> 5, q = lane & 15, hsel = (lane >> 4) & 1;
    const size_t rowbase = (size_t)b * SEQ; const int t0 = qg * 16, nvis = ((t0 >> 6) + 1) * 64;
    const bf16* QI = (const bf16*)(F.ws + WS_QI); const bf16* KI = (const bf16*)(F.ws + WS_KI); const float* WI = (const float*)(F.ws + WS_WI); u16* IDX = (u16*)(F.ws + WS_IDX);
    LAS float* SC = (LAS float*)(L + IX_SC); LAS u16* ID = (LAS u16*)(L + IX_ID); LAS unsigned* CNT = (LAS unsigned*)(L + IX_CNT); LAS float* TAU = (LAS float*)(L + IX_TAU);
#pragma unroll
    for (int i = 0; i < 4; ++i) { const int ci = tid + 512 * i, qq = ci >> 7, rem = ci & 127, hh = rem >> 3, ch = rem & 7;
        *(LAS v4u*)(L + IX_QS + (hh * 16 + qq) * 144 + ch * 16) = *(const GAS v4u*)(QI + (rowbase + t0 + qq) * 1024 + hh * 64 + ch * 8); }
    if (tid < 16) { CNT[tid] = 0u; TAU[tid] = -INFINITY; }
    float wv[8];
#pragma unroll
    for (int hp = 0; hp < 8; ++hp) wv[hp] = WI[(rowbase + t0 + q) * 16 + 2 * hp + hsel];
    __syncthreads();
    for (int r0 = 0; r0 < nvis; r0 += 256) {
        const int kbase = r0 + wave * 32;
        if (kbase < nvis) {
            bf16x8 af[4];
#pragma unroll
            for (int ks = 0; ks < 4; ++ks) af[ks] = *(const GAS bf16x8*)(KI + (rowbase + kbase + r32) * 64 + 16 * ks + 8 * hi);
            f32x16 acc;
#pragma unroll
            for (int r = 0; r < 16; ++r) acc[r] = 0.f;
#pragma unroll
            for (int hp = 0; hp < 8; ++hp) {
                f32x16 c;
#pragma unroll
                for (int r = 0; r < 16; ++r) c[r] = 0.f;
                const LAS unsigned char* qrow = L + IX_QS + ((2 * hp + hsel) * 16 + q) * 144 + hi * 16;
#pragma unroll
                for (int ks = 0; ks < 4; ++ks) { const bf16x8 bq = *(const LAS bf16x8*)(qrow + ks * 32); c = __builtin_amdgcn_mfma_f32_32x32x16_bf16(af[ks], bq, c, 0, 0, 0); }
#pragma unroll
                for (int r = 0; r < 16; ++r) acc[r] += wv[hp] * fmaxf(c[r], 0.f);
            }
#pragma unroll
            for (int r = 0; r < 16; ++r) acc[r] += __shfl_xor(acc[r], 16);
            const float tau = TAU[q];
            float sv[8]; int np = 0;
#pragma unroll
            for (int j = 0; j < 8; ++j) { sv[j] = hsel ? acc[8 + j] : acc[j]; np += (sv[j] > tau) ? 1 : 0; }
            if (np > 0) {
                unsigned pos = atomicAdd((unsigned*)(CNT + q), (unsigned)np);
                const int kb0 = kbase + 16 * hsel + 4 * hi;
#pragma unroll
                for (int j = 0; j < 8; ++j) if (sv[j] > tau) { SC[q * IX_CAP + pos] = sv[j]; ID[q * IX_CAP + pos] = (u16)(kb0 + (j & 3) + 8 * (j >> 2)); ++pos; }
            }
        }
        __syncthreads();
#pragma unroll 1
        for (int qq = 2 * wave; qq < 2 * wave + 2; ++qq) { const int n = (int)CNT[qq];
            if (n > 512) { const float t = select256(SC + qq * IX_CAP, ID + qq * IX_CAP, n, (LAS unsigned*)(L + IX_HIST) + wave * 256, lane); if (lane == 0) { CNT[qq] = 256u; TAU[qq] = t; } } }
        __syncthreads();
    }
#pragma unroll 1
    for (int qq = 2 * wave; qq < 2 * wave + 2; ++qq) { const int n = (int)CNT[qq];
        if (n > 256) { (void)select256(SC + qq * IX_CAP, ID + qq * IX_CAP, n, (LAS unsigned*)(L + IX_HIST) + wave * 256, lane); if (lane == 0) CNT[qq] = 256u; } }
    __syncthreads();
    { const int qq = tid >> 5, n = (int)CNT[qq];
#pragma unroll
      for (int j = 0; j < 8; ++j) { const int i = (tid & 31) + 32 * j; IDX[(rowbase + t0 + qq) * 256 + i] = i < n ? ID[qq * IX_CAP + i] : (u16)0xFFFF; } }
    __syncthreads();
}
__device__ __forceinline__ void p10_indexer(Frame& F) {
    for (int i = 0; i < 1024; i += F.G) {
        const int s = i + F.vcu; if (s >= 1024) break;
        const int j = s >> 8, c = s & 255;
        const int v = (j == 0) ? c : (j == 1) ? 511 - c : (j == 2) ? 512 + c : 1023 - c;
        idx_unit(F, v & 1, v >> 1);
    }
}
constexpr int SP_ROWB = 416, SP_WAVE_BYTES = 32 * SP_ROWB;
__device__ __forceinline__ void sparse_query(Frame& F, int row) {
    const int lane = F.lane, r16 = lane & 15, g = lane >> 4, b = row >> 13;
    LAS unsigned char* vb = F.lds + RING_OFF + F.wave * SP_WAVE_BYTES;
    const u16* ix = (const u16*)(F.ws + WS_IDX) + (size_t)row * 256;
    bf16* qrow = (bf16*)(F.ws + WS_QD) + (size_t)row * 4096;
    const bf16* KL = (const bf16*)(F.ws + WS_KL) + (size_t)b * SEQ * 256;
    bf16x8 qf[8];
#pragma unroll
    for (int ks = 0; ks < 8; ++ks) qf[ks] = *(const GAS bf16x8*)(qrow + r16 * 256 + 32 * ks + 8 * g);
    f32x4 ctx[12];
#pragma unroll
    for (int ct = 0; ct < 12; ++ct) ctx[ct] = (f32x4){0.f, 0.f, 0.f, 0.f};
    float mrun = -INFINITY, lrun = 0.f;
    const int trd = (4 * g + (r16 >> 2)) * SP_ROWB + (r16 & 3) * 8;
#pragma unroll 1
    for (int s = 0; s < 8; ++s) {
        f32x4 S0 = (f32x4){0.f, 0.f, 0.f, 0.f}, S1 = S0;
#pragma unroll
        for (int tt = 0; tt < 2; ++tt) {
            const unsigned key = ix[32 * s + 16 * tt + r16];
            const bf16* kp = KL + (size_t)(key == 0xFFFFu ? 0u : key) * 256 + 8 * g;
            bf16x8 af[8];
#pragma unroll
            for (int ks = 0; ks < 8; ++ks) af[ks] = *(const GAS bf16x8*)(kp + 32 * ks);
#pragma unroll
            for (int ks = 0; ks < 8; ++ks) { if (tt == 0) S0 = __builtin_amdgcn_mfma_f32_16x16x32_bf16(af[ks], qf[ks], S0, 0, 0, 0); else S1 = __builtin_amdgcn_mfma_f32_16x16x32_bf16(af[ks], qf[ks], S1, 0, 0, 0); }
#pragma unroll
            for (int ks = 2; ks < 8; ++ks) *(LAS bf16x8*)(vb + (16 * tt + r16) * SP_ROWB + (32 * (ks - 2) + 8 * g) * 2) = af[ks];
        }
        const v2u i0 = *(const GAS v2u*)(ix + 32 * s + 4 * g), i1 = *(const GAS v2u*)(ix + 32 * s + 16 + 4 * g);
        float x[8];
        x[0] = (i0.x & 0xffffu) == 0xffffu ? -INFINITY : S0[0] * DSA_SCALE; x[1] = (i0.x >> 16) == 0xffffu ? -INFINITY : S0[1] * DSA_SCALE;
        x[2] = (i0.y & 0xffffu) == 0xffffu ? -INFINITY : S0[2] * DSA_SCALE; x[3] = (i0.y >> 16) == 0xffffu ? -INFINITY : S0[3] * DSA_SCALE;
        x[4] = (i1.x & 0xffffu) == 0xffffu ? -INFINITY : S1[0] * DSA_SCALE; x[5] = (i1.x >> 16) == 0xffffu ? -INFINITY : S1[1] * DSA_SCALE;
        x[6] = (i1.y & 0xffffu) == 0xffffu ? -INFINITY : S1[2] * DSA_SCALE; x[7] = (i1.y >> 16) == 0xffffu ? -INFINITY : S1[3] * DSA_SCALE;
        float cm = fmaxf(fmaxf(fmaxf(x[0], x[1]), fmaxf(x[2], x[3])), fmaxf(fmaxf(x[4], x[5]), fmaxf(x[6], x[7])));
        cm = fmaxf(cm, __shfl_xor(cm, 16)); cm = fmaxf(cm, __shfl_xor(cm, 32));
        const float mnew = fmaxf(mrun, cm), alpha = __expf(mrun - mnew);
        float ps = 0.f;
#pragma unroll
        for (int i = 0; i < 8; ++i) { x[i] = __expf(x[i] - mnew); ps += x[i]; }
        lrun = lrun * alpha + ps; mrun = mnew;
        if (__any(alpha != 1.f)) {
#pragma unroll
            for (int ct = 0; ct < 12; ++ct) ctx[ct] = ctx[ct] * alpha; }
        const v4u pw = (v4u){cvtpk(x[0], x[1]), cvtpk(x[2], x[3]), cvtpk(x[4], x[5]), cvtpk(x[6], x[7])};
        const bf16x8 pf = __builtin_bit_cast(bf16x8, pw);
#pragma unroll
        for (int ct = 0; ct < 12; ++ct) {
            const s16x4 lo = vtr(vb + trd + ct * 32), hh = vtr(vb + trd + 16 * SP_ROWB + ct * 32);
            const bf16x8 vf = (bf16x8){lo[0], lo[1], lo[2], lo[3], hh[0], hh[1], hh[2], hh[3]};
            ctx[ct] = __builtin_amdgcn_mfma_f32_16x16x32_bf16(vf, pf, ctx[ct], 0, 0, 0);
        }
    }
    lrun += __shfl_xor(lrun, 16); lrun += __shfl_xor(lrun, 32);
    const float inv = 1.f / lrun;
#pragma unroll
    for (int ct = 0; ct < 12; ++ct) { const f32x4 v = ctx[ct] * inv; *(GAS v2u*)(qrow + r16 * 192 + 16 * ct + 4 * g) = (v2u){cvtpk(v[0], v[1]), cvtpk(v[2], v[3])}; }
}
__device__ __forceinline__ void p11_sparse(Frame& F) {
    const int gw = F.vcu * NWAVES + F.wave, NGW = F.G * NWAVES;
    for (int row = gw; row < M; row += NGW) sparse_query(F, row);
}
__global__ void __launch_bounds__(NWAVES * 64, 2) mk_fwd(Args args) {
    extern __shared__ __attribute__((aligned(16))) unsigned char lds[];
    Frame F;
    F.lds = (LAS unsigned char*)lds;
    F.MISC = (volatile LAS unsigned*)(F.lds + MISC_OFF);
    F.tid = threadIdx.x; F.lane = F.tid & 63; F.wave = __builtin_amdgcn_readfirstlane(F.tid >> 6);
    F.G = gridDim.x; { const int bx = blockIdx.x; F.vcu = (F.G % 8 == 0) ? (bx % 8) * (F.G / 8) + bx / 8 : bx; }
    F.ws = args.ws; F.out = args.out; F.ctl = (gu32*)(args.ws + WS_CTL);
    for (int u = F.tid; u < (LDS_BYTES - LDSCTL_OFF) / 4; u += NWAVES * 64) ((LAS unsigned*)(F.lds + LDSCTL_OFF))[u] = 0u;
    __syncthreads();
    XcdBarrier bar = xcd_barrier_post((unsigned*)(F.ctl + CW_BAR), F.MISC + 8);
#define GRID_BAR() xcd_barrier(bar)
    unsigned char* ws = args.ws;
    bf16* XB = (bf16*)(ws + WS_XB); bf16* HB = (bf16*)(ws + WS_H);
    const int bx = (int)blockIdx.x;

    p0_prologue(F, args);
    GRID_BAR();
    {   pg8::Gemm g{XB, (const bf16*)(ws + WS_W0IN), M, NQKV0, DM, DM}; pg8::StaticOrder S; S.init(M, NQKV0, F.G, bx);
        pg8::EpiBf16<0> E{(bf16*)(ws + WS_QO), DM, nullptr, DM, (size_t)(WS_K - WS_QO) / 2, 0.125f};
        pg8::gemm_phase<pg8::EpiBf16<0>, pg8::StaticOrder, PG8_ALIGN, PG8_SP2>(F.lds + RING_OFF, g, S, E); }
    GRID_BAR();
    p1b_scan_kn(F);
    GRID_BAR();
    p2_attention(F);
    GRID_BAR();
    {   pg8::Gemm g{(const bf16*)(ws + WS_QO), (const bf16*)(ws + WS_W0O), M, DM, DM, DM}; pg8::StaticOrder S; S.init(M, DM, F.G, bx);
        pg8::EpiResF32 E{args.in[0], F.out, DM, ALPHA};
        pg8::gemm_phase<pg8::EpiResF32, pg8::StaticOrder, PG8_ALIGN, PG8_SP2>(F.lds + RING_OFF, g, S, E); }
    GRID_BAR();
    ln_phase(F, F.out, args.in[5], args.in[6], XB);
    GRID_BAR();
    {   pg8::Gemm g{XB, (const bf16*)(ws + WS_W0UP), M, FF2, DM, DM}; pg8::StaticOrder S; S.init(M, FF2, F.G, bx);
        pg8::EpiBf16<0> E{HB, FF2, nullptr, 0, 0, 1.f};
        pg8::gemm_phase<pg8::EpiBf16<0>, pg8::StaticOrder, PG8_ALIGN, PG8_SP2>(F.lds + RING_OFF, g, S, E); }
    GRID_BAR();
    conv_phase(F, HB, args.in[8], args.in[9]);
    GRID_BAR();
    {   pg8::Gemm g{HB + FF, (const bf16*)(ws + WS_W0DN), M, DM, FF, FF2}; pg8::StaticOrder S; S.init(M, DM, F.G, bx);
        pg8::EpiResF32 E{F.out, F.out, DM, ALPHA};
        pg8::gemm_phase<pg8::EpiResF32, pg8::StaticOrder, PG8_ALIGN, PG8_SP2>(F.lds + RING_OFF, g, S, E); }
    GRID_BAR();
    ln_phase(F, F.out, args.in[11], args.in[12], XB);
    p8_prep(F, args);
    GRID_BAR();
    {   pg8::Gemm g{XB, (const bf16*)(ws + WS_W1IN), M, N1PAD, DM, DM}; pg8::StaticOrder S; S.init(M, N1PAD, F.G, bx);
        pg8::EpiL1In E{(bf16*)(ws + WS_QD), (bf16*)(ws + WS_KL), (bf16*)(ws + WS_QI), (bf16*)(ws + WS_KI), (float*)(ws + WS_WI), (const float*)(ws + WS_CSQ), (const float*)(ws + WS_CSI), IDX_SCALE};
        pg8::gemm_phase<pg8::EpiL1In, pg8::StaticOrder, PG8_ALIGN, PG8_SP2>(F.lds + RING_OFF, g, S, E); }
    GRID_BAR();
    p10_indexer(F);
    GRID_BAR();
    p11_sparse(F);
    GRID_BAR();
    {   pg8::Gemm g{(const bf16*)(ws + WS_QD), (const bf16*)(ws + WS_WC), M, DM, 3072, 4096}; pg8::StaticOrder S; S.init(M, DM, F.G, bx);
        pg8::EpiResF32 E{F.out, F.out, DM, ALPHA};
        pg8::gemm_phase<pg8::EpiResF32, pg8::StaticOrder, PG8_ALIGN, PG8_SP2>(F.lds + RING_OFF, g, S, E); }
    GRID_BAR();
    ln_phase(F, F.out, args.in[16], args.in[17], XB);
    GRID_BAR();
    {   pg8::Gemm g{XB, (const bf16*)(ws + WS_W1UP), M, FF2, DM, DM}; pg8::StaticOrder S; S.init(M, FF2, F.G, bx);
        pg8::EpiBf16<0> E{HB, FF2, nullptr, 0, 0, 1.f};
        pg8::gemm_phase<pg8::EpiBf16<0>, pg8::StaticOrder, PG8_ALIGN, PG8_SP2>(F.lds + RING_OFF, g, S, E); }
    GRID_BAR();
    conv_phase(F, HB, args.in[19], args.in[20]);
    GRID_BAR();
    {   pg8::Gemm g{HB + FF, (const bf16*)(ws + WS_W1DN), M, DM, FF, FF2}; pg8::StaticOrder S; S.init(M, DM, F.G, bx);
        pg8::EpiResF32 E{F.out, F.out, DM, ALPHA};
        pg8::gemm_phase<pg8::EpiResF32, pg8::StaticOrder, PG8_ALIGN, PG8_SP2>(F.lds + RING_OFF, g, S, E); }
    GRID_BAR();
    ln_phase(F, F.out, args.in[22], args.in[23], nullptr);
#undef GRID_BAR
}

extern "C" void kernel_launch(void* const* d_in, const int* in_sizes, int n_in, void* d_out, int out_size, void* d_ws, size_t ws_size, hipStream_t stream) {
    static int grid = 0;
    if (grid == 0) {
        if (n_in != NIN || in_sizes[0] != M * DM || out_size != M * DM || ws_size < WS_END) { fprintf(stderr, "kernel_launch: unexpected shapes (n_in %d, in0 %d, out %d, ws %zu); nothing launched\n", n_in, n_in > 0 ? in_sizes[0] : -1, out_size, ws_size); grid = -1; return; }
        int dev = 0, cus = 0, per_cu = 0;
        if (hipGetDevice(&dev) != hipSuccess || hipDeviceGetAttribute(&cus, hipDeviceAttributeMultiprocessorCount, dev) != hipSuccess) { grid = -1; return; }
        if (hipFuncSetAttribute((const void*)mk_fwd, hipFuncAttributeMaxDynamicSharedMemorySize, LDS_BYTES) != hipSuccess) { fprintf(stderr, "kernel_launch: hipFuncSetAttribute failed\n"); grid = -1; return; }
        if (hipOccupancyMaxActiveBlocksPerMultiprocessor(&per_cu, (const void*)mk_fwd, NWAVES * 64, LDS_BYTES) != hipSuccess || per_cu < 1) fprintf(stderr, "kernel_launch: occupancy query reports %d workgroups per CU\n", per_cu);
        (void)hipGetLastError();
        grid = cus;
    }
    if (grid < 0) return;
    if (hipMemsetAsync((char*)d_ws + WS_CTL, 0, CTL_ZERO_BYTES, stream) != hipSuccess) { fprintf(stderr, "kernel_launch: hipMemsetAsync failed\n"); return; }
    Args a{};
    for (int i = 0; i < NIN; ++i) a.in[i] = (const float*)d_in[i];
    a.out = (float*)d_out; a.ws = (unsigned char*)d_ws;
    hipLaunchKernelGGL(mk_fwd, dim3(grid), dim3(NWAVES * 64), LDS_BYTES, stream, a);
    const hipError_t le = hipPeekAtLastError();
    if (le != hipSuccess) fprintf(stderr, "kernel_launch: launch failed: %s\n", hipGetErrorName(le));
}
```

```cpp
#include <hip/hip_runtime.h>
#include <cstdio>
#include <cstdint>
namespace pg8 {
#define PG8_LAS __attribute__((address_space(3)))
typedef unsigned short bf16_t;
typedef short bf16x8 __attribute__((ext_vector_type(8)));
typedef float f32x4 __attribute__((ext_vector_type(4)));
typedef unsigned u32x4 __attribute__((ext_vector_type(4)));
constexpr int BM = 256, BK = 64, HALF = 128, HTB = HALF * BK * 2  , STAGE_BYTES = 8 * HTB, NXCD = 8, WGM = 8;

__host__ __device__ __forceinline__ int lds_byte(int r, int c) { const int st = (r >> 4) * 2 + (c >> 5), rr = r & 15, cc = c & 31, ob = rr * 64 + cc * 2; return st * 1024 + (ob ^ (((ob >> 9) & 1) << 5)); }
__host__ __device__ __forceinline__ void stage_rc(int b, int& R, int& C) { const int st = b / 1024, sb = b % 1024, swz = sb ^ (((sb >> 9) & 1) << 5); R = (st >> 1) * 16 + swz / 64; C = (st & 1) * 32 + (swz % 64) / 2; }
__host__ __device__ __forceinline__ int perm32(int rho) { const int n = rho >> 4, i = rho & 15; return 8 * (i >> 2) + 4 * n + (i & 3); }

struct Unit { int pm, pn; };
struct Gemm { const bf16_t* A; const bf16_t* Bt; int M, N, K, lda; };

struct StaticOrder {
    int nM, nN, nwg, G, c;
    __host__ __device__ void init(int M, int N, int G_, int c_) { nM = M / BM; nN = N / BM; nwg = nM * nN; G = G_; c = c_; }
    __host__ __device__ bool next(int i, Unit& u) const {
        const long L = (long)i * G + c; if (L >= nwg) return false;
        int wgid = (int)L; { const int q = nwg / NXCD, r = nwg % NXCD, xcd = wgid % NXCD, off = wgid / NXCD; wgid = (xcd < r ? xcd * (q + 1) : r * (q + 1) + (xcd - r) * q) + off; }
        const int nig = WGM * nN, gid = wgid / nig, fm = gid * WGM, gsz = (nM - fm) < WGM ? (nM - fm) : WGM;
        u.pm = fm + ((wgid % nig) % gsz); u.pn = (wgid % nig) / gsz; return true;
    }
    __device__ __forceinline__ void a_ready(const Unit&) const {}
    __device__ __forceinline__ void done(const Unit&) const {}
};

__device__ __forceinline__ unsigned cvt_pk_bf16(float lo, float hi) { unsigned r; asm volatile("v_cvt_pk_bf16_f32 %0, %1, %2" : "=v"(r) : "v"(lo), "v"(hi)); return r; }
typedef float f32x2 __attribute__((ext_vector_type(2)));
__device__ __forceinline__ f32x2 gelu_pk(f32x2 v) {
    const f32x2 av = __builtin_elementwise_abs(v), d = av * 0.2316418882f + 1.0f;
    f32x2 t; t.x = __builtin_amdgcn_rcpf(d.x); t.y = __builtin_amdgcn_rcpf(d.y);
    f32x2 q = t * 0.5307027145f + (-0.7265760135f); q = q * t + 0.7107068705f; q = q * t + (-0.142248368f); q = q * t + 0.127414796f; q = q * t;
    const f32x2 s = (v * v) * (-0.72134752044f);
    f32x2 e; e.x = __builtin_amdgcn_exp2f(s.x); e.y = __builtin_amdgcn_exp2f(s.y);
    const f32x2 m = v * (q * e), r = v - m;
    f32x2 o; o.x = v.x < 0.f ? m.x : r.x; o.y = v.y < 0.f ? m.y : r.y; return o;
}

template <int ACT  > struct EpiBf16 {
    static constexpr bool PERM = true, AFTER_DRAIN = false; static_assert(ACT == 0 || ACT == 1, "EpiBf16: ACT is 0 (none) or 1 (gelu_pk)");
    bf16_t* O; int ldc; const float* bias; int split_cols; size_t split_stride; float scale0;
    __device__ __forceinline__ void operator()(const f32x4 (&acc)[2][2][4][2], const Unit& u, int wr, int wc, int fr, int fq) const {
        const int row0 = u.pm * BM + wr * 64 + fr; int colt = u.pn * BM; bf16_t* base = O;
        float sc = 1.f; if (split_cols) { const int t = colt / split_cols; base += (size_t)t * split_stride; colt -= t * split_cols; if (t == 0) sc = scale0; }
        const int col0 = colt + wc * 32 + 8 * fq, bcol0 = u.pn * BM + wc * 32 + 8 * fq;
        f32x4 bv[2][2];
#pragma unroll
        for (int bj = 0; bj < 2; ++bj)
#pragma unroll
            for (int n = 0; n < 2; ++n) bv[bj][n] = bias ? *(const f32x4*)(bias + bcol0 + bj * HALF + 4 * n) : (f32x4){0.f, 0.f, 0.f, 0.f};
#pragma unroll
        for (int ai = 0; ai < 2; ++ai)
#pragma unroll
            for (int m = 0; m < 4; ++m) { bf16_t* rowp = base + (size_t)(row0 + ai * HALF + m * 16) * ldc + col0;
#pragma unroll
                for (int bj = 0; bj < 2; ++bj) { f32x4 v0 = acc[ai][bj][m][0] + bv[bj][0], v1 = acc[ai][bj][m][1] + bv[bj][1];
                    if (ACT == 1) { f32x2 a = gelu_pk((f32x2){v0[0], v0[1]}), b = gelu_pk((f32x2){v0[2], v0[3]}), c = gelu_pk((f32x2){v1[0], v1[1]}), d = gelu_pk((f32x2){v1[2], v1[3]});
                        v0 = (f32x4){a.x, a.y, b.x, b.y}; v1 = (f32x4){c.x, c.y, d.x, d.y}; }
                    v0 = v0 * sc; v1 = v1 * sc; u32x4 w; w.x = cvt_pk_bf16(v0[0], v0[1]); w.y = cvt_pk_bf16(v0[2], v0[3]); w.z = cvt_pk_bf16(v1[0], v1[1]); w.w = cvt_pk_bf16(v1[2], v1[3]);
                    *(u32x4*)(rowp + bj * HALF) = w; } }
    }
};
template <class Epi, class Sched, bool ALIGN_EPI = false, bool SP2 = false>
__device__ __forceinline__ void gemm_phase(PG8_LAS unsigned char* lds, const Gemm g, const Sched& S, const Epi& E) {
    int tid_ = threadIdx.x; asm volatile("" : "+v"(tid_));
    const int tid = tid_, wid = __builtin_amdgcn_readfirstlane(tid >> 6), lane = tid & 63, wr = wid >> 2, wc = wid & 3, fr = lane & 15, fq = lane >> 4;
    const int K = g.K, nt = K / BK;
    unsigned voffA[2], voffB[2];
#pragma unroll
    for (int i = 0; i < 2; ++i) { int R, C; stage_rc(tid * 16 + i * 8192, R, C); const int Rb = Epi::PERM ? ((R & ~31) + perm32(R & 31)) : R;
        voffA[i] = (unsigned)(R * g.lda + C) * 2u; voffB[i] = (unsigned)(Rb * K + C) * 2u; }
    const size_t kstep = (size_t)(BK * 2);
    const size_t hstepB = (size_t)HALF * K * 2, hstepA = (size_t)HALF * g.lda * 2;
    const size_t tstepA = 2 * hstepA, tstepB = 2 * hstepB;
    const unsigned ldsw = (unsigned)wid * 1024u;
    const int aoff = lds_byte(wr * 64 + fr, fq * 8), boff = lds_byte(wc * 32 + fr, fq * 8);
#define PG8_SA(b, h) (((b) * 2 + (h)) * HTB)
#define PG8_SB(b, h) ((4 + (b) * 2 + (h)) * HTB)
#define PG8_STAGE(bufoff, gbase, voff) do { _Pragma("unroll") for (int _i = 0; _i < 2; ++_i) \
        __builtin_amdgcn_global_load_lds((const unsigned*)((const char*)(gbase) + (voff)[_i]), (PG8_LAS unsigned*)(lds + (bufoff) + ldsw + _i * 8192), 16, 0, 0); } while (0)
#define PG8_LDA(dst, b, h) do { _Pragma("unroll") for (int m = 0; m < 4; ++m) _Pragma("unroll") for (int k = 0; k < 2; ++k) dst[m][k] = *(const PG8_LAS bf16x8*)(lds + PG8_SA(b, h) + aoff + m * 2048 + k * 1024); } while (0)
#define PG8_LDB(dst, b, h) do { _Pragma("unroll") for (int n = 0; n < 2; ++n) _Pragma("unroll") for (int k = 0; k < 2; ++k) dst[n][k] = *(const PG8_LAS bf16x8*)(lds + PG8_SB(b, h) + boff + n * 2048 + k * 1024); } while (0)
#define PG8_MMA(ai, bj, At, Bt) do { __builtin_amdgcn_s_setprio(1); _Pragma("unroll") for (int m = 0; m < 4; ++m) _Pragma("unroll") for (int n = 0; n < 2; ++n) _Pragma("unroll") for (int k = 0; k < 2; ++k) \
        acc[ai][bj][m][n] = __builtin_amdgcn_mfma_f32_16x16x32_bf16(Bt[n][k], At[m][k], acc[ai][bj][m][n], 0, 0, 0); __builtin_amdgcn_s_setprio(0); } while (0)
#define PG8_WAIT_V(n) asm volatile("s_waitcnt vmcnt(" #n ")" ::: "memory")
#define PG8_WAIT_L(n) asm volatile("s_waitcnt lgkmcnt(" #n ")" ::: "memory")
#define PG8_BAR __builtin_amdgcn_s_barrier()
#define PG8_SCHED __builtin_amdgcn_sched_barrier(0)
    Unit cur, nxt; int ui = 0;
    if (!S.next(0, cur)) return;
    f32x4 acc[2][2][4][2];
#pragma unroll
    for (int a = 0; a < 2; ++a)
#pragma unroll
        for (int b = 0; b < 2; ++b)
#pragma unroll
            for (int m = 0; m < 4; ++m)
#pragma unroll
                for (int n = 0; n < 2; ++n) acc[a][b][m][n] = (f32x4){0.f, 0.f, 0.f, 0.f};
    bf16x8 At[4][2], B0[2][2], B1[2][2];
    const char* cA = (const char*)g.A + (size_t)cur.pm * tstepA; const char* cB = (const char*)g.Bt + (size_t)cur.pn * tstepB;
    S.a_ready(cur);
    if constexpr (SP2) {
        PG8_STAGE(PG8_SB(0, 0), cB, voffB); PG8_STAGE(PG8_SB(0, 1), cB + hstepB, voffB); PG8_STAGE(PG8_SA(0, 0), cA, voffA); PG8_STAGE(PG8_SA(0, 1), cA + hstepA, voffA);
        if (wr == 1) PG8_BAR;
        PG8_WAIT_V(2); PG8_BAR;
        PG8_STAGE(PG8_SB(1, 0), cB + kstep, voffB); PG8_STAGE(PG8_SA(1, 0), cA + kstep, voffA); PG8_STAGE(PG8_SB(1, 1), cB + hstepB + kstep, voffB);
        PG8_WAIT_V(6); PG8_BAR;
    } else {
        PG8_STAGE(PG8_SB(0, 0), cB, voffB); PG8_STAGE(PG8_SA(0, 0), cA, voffA); PG8_STAGE(PG8_SB(0, 1), cB + hstepB, voffB); PG8_STAGE(PG8_SA(0, 1), cA + hstepA, voffA);
        if (wr == 1) PG8_BAR;
        PG8_WAIT_V(4); PG8_BAR;
        PG8_STAGE(PG8_SB(1, 0), cB + kstep, voffB); PG8_STAGE(PG8_SA(1, 0), cA + kstep, voffA); PG8_STAGE(PG8_SB(1, 1), cB + hstepB + kstep, voffB);
        PG8_WAIT_V(6); PG8_BAR;
    }
    for (;;) {
        const bool has_next = S.next(ui + 1, nxt);
        const char* nA = has_next ? (const char*)g.A + (size_t)nxt.pm * tstepA : cA; const char* nB = has_next ? (const char*)g.Bt + (size_t)nxt.pn * tstepB : cB;
        for (int t = 0; t < nt; t += 2) {
            const bool last = (t == nt - 2);
            const char* a1 = cA + (size_t)(t + 1) * kstep;
            const char* a2 = last ? nA : cA + (size_t)(t + 2) * kstep; const char* b2 = last ? nB : cB + (size_t)(t + 2) * kstep;
            const char* a3 = a2 + kstep; const char* b3 = b2 + kstep;
            if (last && has_next) S.a_ready(nxt);
            if constexpr (SP2) {
            PG8_LDB(B0, 0, 0); PG8_LDB(B1, 0, 1); PG8_SCHED; PG8_LDA(At, 0, 0); PG8_STAGE(PG8_SA(1, 1), a1 + hstepA, voffA);
            PG8_WAIT_V(8); PG8_WAIT_L(0); PG8_BAR; PG8_MMA(0, 0, At, B0); PG8_MMA(0, 1, At, B1); PG8_BAR; PG8_SCHED;
            PG8_LDA(At, 0, 1); PG8_STAGE(PG8_SB(0, 0), b2, voffB); PG8_STAGE(PG8_SB(0, 1), b2 + hstepB, voffB); PG8_STAGE(PG8_SA(0, 0), a2, voffA);
            PG8_WAIT_V(8); PG8_WAIT_L(0); PG8_BAR; PG8_MMA(1, 0, At, B0); PG8_MMA(1, 1, At, B1); PG8_BAR; PG8_SCHED;
            PG8_LDB(B0, 1, 0); PG8_LDB(B1, 1, 1); PG8_SCHED; PG8_LDA(At, 1, 0); PG8_STAGE(PG8_SA(0, 1), a2 + hstepA, voffA);
            PG8_WAIT_V(8); PG8_WAIT_L(0); PG8_BAR; PG8_MMA(0, 0, At, B0); PG8_MMA(0, 1, At, B1); PG8_BAR; PG8_SCHED;
            PG8_LDA(At, 1, 1); PG8_STAGE(PG8_SB(1, 0), b3, voffB); PG8_STAGE(PG8_SB(1, 1), b3 + hstepB, voffB); PG8_STAGE(PG8_SA(1, 0), a3, voffA);
            PG8_WAIT_V(8); PG8_WAIT_L(0); PG8_BAR; PG8_MMA(1, 0, At, B0); PG8_MMA(1, 1, At, B1); PG8_BAR; PG8_SCHED;
            } else {
            PG8_LDB(B0, 0, 0); PG8_SCHED; PG8_LDA(At, 0, 0); PG8_STAGE(PG8_SA(1, 1), a1 + hstepA, voffA);
            PG8_WAIT_L(8); PG8_BAR; PG8_WAIT_L(0); PG8_MMA(0, 0, At, B0); PG8_BAR; PG8_SCHED;
            PG8_LDB(B1, 0, 1); PG8_STAGE(PG8_SB(0, 0), b2, voffB);
            PG8_BAR; PG8_WAIT_L(0); PG8_MMA(0, 1, At, B1); PG8_BAR;
            PG8_LDA(At, 0, 1); PG8_STAGE(PG8_SA(0, 0), a2, voffA);
            PG8_BAR; PG8_WAIT_L(0); PG8_MMA(1, 0, At, B0); PG8_BAR; PG8_SCHED;
            PG8_STAGE(PG8_SB(0, 1), b2 + hstepB, voffB);
            PG8_WAIT_V(6); PG8_BAR; PG8_MMA(1, 1, At, B1); PG8_BAR;
            PG8_LDB(B0, 1, 0); PG8_SCHED; PG8_LDA(At, 1, 0); PG8_STAGE(PG8_SA(0, 1), a2 + hstepA, voffA);
            PG8_WAIT_L(8); PG8_BAR; PG8_WAIT_L(0); PG8_MMA(0, 0, At, B0); PG8_BAR; PG8_SCHED;
            PG8_LDB(B1, 1, 1); PG8_STAGE(PG8_SB(1, 0), b3, voffB);
            PG8_BAR; PG8_WAIT_L(0); PG8_MMA(0, 1, At, B1); PG8_BAR;
            PG8_LDA(At, 1, 1); PG8_STAGE(PG8_SA(1, 0), a3, voffA);
            PG8_BAR; PG8_WAIT_L(0); PG8_MMA(1, 0, At, B0); PG8_BAR; PG8_SCHED;
            PG8_STAGE(PG8_SB(1, 1), b3 + hstepB, voffB);
            PG8_WAIT_V(6); PG8_BAR; PG8_MMA(1, 1, At, B1); PG8_BAR;
            }
        }
        if constexpr (ALIGN_EPI) { if (wr == 0) PG8_BAR; }
        if constexpr (!Epi::AFTER_DRAIN) { E(acc, cur, wr, wc, fr, fq); S.done(cur); }
        if (!has_next) break;
#pragma unroll
        for (int a = 0; a < 2; ++a)
#pragma unroll
            for (int b = 0; b < 2; ++b)
#pragma unroll
                for (int m = 0; m < 4; ++m)
#pragma unroll
                    for (int n = 0; n < 2; ++n) acc[a][b][m][n] = (f32x4){0.f, 0.f, 0.f, 0.f};
        cur = nxt; cA = nA; cB = nB; ++ui;
        if constexpr (ALIGN_EPI) { if (wr == 1) PG8_BAR; }
    }
    PG8_WAIT_V(0);
    if constexpr (!ALIGN_EPI) { if (wr == 0) PG8_BAR; }
    PG8_BAR;
    if constexpr (Epi::AFTER_DRAIN) { E.fused(acc, cur, wr, wc, fr, fq, lds, wid, lane); S.done(cur); }
#undef PG8_SA
#undef PG8_SB
#undef PG8_STAGE
#undef PG8_LDA
#undef PG8_LDB
#undef PG8_MMA
#undef PG8_WAIT_V
#undef PG8_WAIT_L
#undef PG8_BAR
#undef PG8_SCHED
}
}

#ifndef PG8_SP2
#define PG8_SP2 true
#endif
#ifndef PG8_ALIGN
#define PG8_ALIGN true
#endif
namespace pg8 {
struct EpiResF32 {
    static constexpr bool PERM = false, AFTER_DRAIN = false;
    const float* base; float* out; int ldc; float alpha;
    __device__ __forceinline__ void operator()(const f32x4 (&acc)[2][2][4][2], const Unit& u, int wr, int wc, int fr, int fq) const {
        const int col0 = u.pn * BM + wc * 32 + 4 * fq;
#pragma unroll
        for (int ai = 0; ai < 2; ++ai)
#pragma unroll
            for (int m = 0; m < 4; ++m) { const size_t off = (size_t)(u.pm * BM + ai * HALF + wr * 64 + m * 16 + fr) * ldc + col0;
#pragma unroll
                for (int bj = 0; bj < 2; ++bj)
#pragma unroll
                    for (int n = 0; n < 2; ++n) { const f32x4 bs = *(const f32x4*)(base + off + bj * HALF + n * 16); *(f32x4*)(out + off + bj * HALF + n * 16) = bs * alpha + acc[ai][bj][m][n]; }
                asm volatile("" ::: "memory"); }
    }
};
struct EpiL1In {
    static constexpr bool PERM = true, AFTER_DRAIN = false;
    bf16_t *Qd, *KL, *QI, *KI; float* WI; const float* csq; const float* csi; float wscale;
    __device__ __forceinline__ void operator()(const f32x4 (&acc)[2][2][4][2], const Unit& u, int wr, int wc, int fr, int fq) const {
        const int pn = u.pn, row0 = u.pm * BM + wr * 64 + fr;
#pragma unroll
        for (int bj = 0; bj < 2; ++bj) {
            const int c0 = bj * HALF + wc * 32 + 8 * fq;
            int kind = 0, pb = 0, ld = 0, dcol = 0; bf16_t* dst = nullptr; bool f32out = false, skip = false;
            if (pn < 16) { dst = Qd; ld = 4096; dcol = pn * 256 + c0; kind = c0 < 64 ? 1 : 0; pb = c0 >> 1; }
            else if (pn == 16) { dst = KL; ld = 256; dcol = c0; kind = c0 < 64 ? 1 : 0; pb = c0 >> 1; }
            else if (pn < 21) { dst = QI; ld = 1024; dcol = (pn - 17) * 256 + c0; const int j0 = c0 & 63; kind = j0 < 16 ? 2 : 0; pb = j0 >> 1; }
            else { if (c0 < 64) { dst = KI; ld = 64; dcol = c0; kind = c0 < 16 ? 2 : 0; pb = c0 >> 1; } else if (c0 < 80) { f32out = true; dcol = c0 - 64; } else skip = true; }
            if (skip) continue;
#pragma unroll
            for (int ai = 0; ai < 2; ++ai)
#pragma unroll
                for (int m = 0; m < 4; ++m) { const int row = row0 + ai * HALF + m * 16;
                    f32x4 v0 = acc[ai][bj][m][0], v1 = acc[ai][bj][m][1];
                    if (kind) { const float* cs = (kind == 1 ? csq + (size_t)row * 64 : csi + (size_t)row * 16) + pb * 2;
                        const f32x4 c01 = *(const f32x4*)cs, c23 = *(const f32x4*)(cs + 4);
                        f32x4 r0, r1;
                        r0[0] = v0[0] * c01[0] - v0[1] * c01[1]; r0[1] = v0[1] * c01[0] + v0[0] * c01[1];
                        r0[2] = v0[2] * c01[2] - v0[3] * c01[3]; r0[3] = v0[3] * c01[2] + v0[2] * c01[3];
                        r1[0] = v1[0] * c23[0] - v1[1] * c23[1]; r1[1] = v1[1] * c23[0] + v1[0] * c23[1];
                        r1[2] = v1[2] * c23[2] - v1[3] * c23[3]; r1[3] = v1[3] * c23[2] + v1[2] * c23[3];
                        v0 = r0; v1 = r1; }
                    if (f32out) { float* o = WI + (size_t)row * 16 + dcol; *(f32x4*)o = v0 * wscale; *(f32x4*)(o + 4) = v1 * wscale; }
                    else { u32x4 w; w.x = cvt_pk_bf16(v0[0], v0[1]); w.y = cvt_pk_bf16(v0[2], v0[3]); w.z = cvt_pk_bf16(v1[0], v1[1]); w.w = cvt_pk_bf16(v1[2], v1[3]);
                        *(u32x4*)(dst + (size_t)row * ld + dcol) = w; }
                    asm volatile("" ::: "memory"); }
        }
    }
};
}
constexpr int NWAVES = 8;
constexpr int BATCH = 2, SEQ = 8192, DM = 1024, M = BATCH * SEQ;
constexpr int FF = 2816, FF2 = 2 * FF, NQKV0 = 3072, N1PAD = 5632, W_IN_AB = 3080, W_IN_C = 5456;
constexpr float LN_EPS = 1e-5f, ALPHA = 1.4142135623730951f;
constexpr float IDX_SCALE = 0.03125f, DSA_SCALE = 0.0625f;
constexpr int NIN = 24;
constexpr size_t MiB = 1u << 20;
constexpr size_t WS_CTL = 0, CTL_ZERO_BYTES = 64 * 1024;
constexpr size_t WS_LSF = 1 * MiB, WS_CUM = WS_LSF + 512 * 1024;
constexpr size_t WS_XB = 2 * MiB;
constexpr size_t WS_W0IN = 34 * MiB, WS_W0O = 40 * MiB, WS_W0UP = 42 * MiB, WS_W0DN = 53 * MiB;
constexpr size_t WS_W1IN = 34 * MiB, WS_WC = 45 * MiB, WS_CSQ = 51 * MiB, WS_CSI = 55 * MiB, WS_WI = 56 * MiB, WS_KI = 57 * MiB;
constexpr size_t WS_BIG = 59 * MiB;
constexpr size_t WS_QO = WS_BIG, WS_K = WS_QO + 32 * MiB, WS_V = WS_K + 32 * MiB;
constexpr size_t WS_H = WS_BIG;
constexpr size_t WS_QD = WS_BIG, WS_QI = WS_QD + 128 * MiB, WS_KL = WS_QI + 32 * MiB, WS_IDX = WS_KL + 8 * MiB;
constexpr size_t WS_W1UP = 235 * MiB, WS_W1DN = 246 * MiB, WS_END = 256 * MiB;
static_assert(WS_H + (size_t)M * FF2 * 2 <= WS_W1UP && WS_IDX + (size_t)M * 256 * 2 <= WS_W1UP && WS_W1DN + (size_t)DM * FF * 2 <= WS_END && WS_W0DN + (size_t)DM * FF * 2 <= WS_BIG && WS_KI + (size_t)M * 64 * 2 <= WS_BIG, "d_ws map");
constexpr int CW_TMO = 0, CW_CODE = 1, CW_KN = 64, CW_BAR = 4096;
constexpr int RING_OFF = 0, RING_BYTES = 145408;
constexpr int LDSCTL_OFF = RING_BYTES, MISC_OFF = LDSCTL_OFF + 320;
constexpr int LDS_BYTES = 147456;
#define GAS __attribute__((address_space(1)))
#define LAS __attribute__((address_space(3)))
typedef unsigned short bf16;
typedef unsigned v4u __attribute__((ext_vector_type(4)));
typedef float f32x4 __attribute__((ext_vector_type(4)));
typedef short bf16x8 __attribute__((ext_vector_type(8)));
typedef GAS unsigned gu32;
typedef GAS unsigned long long gu64;
#define RLX_AGENT __ATOMIC_RELAXED, __HIP_MEMORY_SCOPE_AGENT
#define LDS_WAIT() asm volatile("s_waitcnt lgkmcnt(0)" ::: "memory")
#define VM_WAIT() asm volatile("s_waitcnt vmcnt(0)" ::: "memory")
__device__ __forceinline__ unsigned long long rt() { return __builtin_amdgcn_s_memrealtime(); }
__device__ __forceinline__ unsigned f2bf(float f) { unsigned u = __builtin_bit_cast(unsigned, f); return (u + 0x7fffu + ((u >> 16) & 1u)) >> 16; }
__device__ __forceinline__ unsigned pk2(float lo, float hi) { return f2bf(lo) | (f2bf(hi) << 16); }

#define XB_TMO      128
#define XB_XCNT(j)  (256  + 64 * (j))
#define XB_XSUB(j)  (1280 + 64 * (j))
#define XB_XGEN(j)  (2304 + 64 * (j))
#define XB_TOP      3328
#define XB_TOPGEN   3392
#define XCD_BAR_WORDS 3456
#define XB_SPIN_CAP (1u << 18)

__device__ __forceinline__ unsigned xb_ld(unsigned* p)              { return __hip_atomic_load(p, __ATOMIC_RELAXED, __HIP_MEMORY_SCOPE_AGENT); }
__device__ __forceinline__ unsigned xb_add(unsigned* p, unsigned v) { return __hip_atomic_fetch_add(p, v, __ATOMIC_RELAXED, __HIP_MEMORY_SCOPE_AGENT); }
__device__ __forceinline__ unsigned xb_xcc_id() { return (unsigned)__builtin_amdgcn_s_getreg((3 << 11) | 20) & 0xFu; }
#define XB_SPIN(cond, bar) do { unsigned _sp = 0; while (cond) { __builtin_amdgcn_s_sleep(1); \
    if ((++_sp & 255u) == 0u) { if (xb_ld(&(bar)[XB_TMO])) break; if (_sp > XB_SPIN_CAP) { atomicAdd(&(bar)[XB_TMO], 1u); break; } } } } while (0)

struct XcdBarrier {
    unsigned* bar; unsigned x;
    volatile LAS unsigned* st;
};

__device__ __forceinline__ XcdBarrier xcd_barrier_post(unsigned* bar, volatile LAS unsigned* st) {
    XcdBarrier b; b.bar = bar; b.x = xb_xcc_id(); b.st = st;
    if (threadIdx.x == 0) (void)xb_add(&bar[XB_XCNT(b.x)], 1u);
    return b;
}
__device__ __forceinline__ void xcd_barrier_complete(unsigned* bar, unsigned x, unsigned& nloc, unsigned& nx) {
    const unsigned G = gridDim.x * gridDim.y * gridDim.z;
    unsigned sum, cnt, mine, sp = 0u;
    for (;;) {
        sum = 0u; cnt = 0u; mine = 0u;
#pragma unroll
        for (unsigned j = 0; j < 16; ++j) { const unsigned c = xb_ld(&bar[XB_XCNT(j)]); sum += c; cnt += (c > 0u) ? 1u : 0u; mine = (j == x) ? c : mine; }
        if (sum == G) break;
        __builtin_amdgcn_s_sleep(1);
        if ((++sp & 255u) == 0u) { if (xb_ld(&bar[XB_TMO])) break; if (sp > XB_SPIN_CAP) { atomicAdd(&bar[XB_TMO], 1u); break; } }
    }
    nloc = mine > 0u ? mine : 1u; nx = cnt > 0u ? cnt : 1u;
}

__device__ __forceinline__ void xcd_barrier(const XcdBarrier& b) {
    asm volatile("s_waitcnt vmcnt(0)" ::: "memory");
    __syncthreads();
    if (threadIdx.x == 0) {
        unsigned* bar = b.bar;
        __builtin_amdgcn_s_waitcnt(0);
        unsigned nloc = b.st[0], nx = b.st[1];
        if (nloc == 0u) { xcd_barrier_complete(bar, b.x, nloc, nx); b.st[0] = nloc; b.st[1] = nx; }
        const unsigned old = xb_add(&bar[XB_XSUB(b.x)], 1u);
        const unsigned gen = old / nloc;
        if (old + 1u == (gen + 1u) * nloc) {
            __builtin_amdgcn_fence(__ATOMIC_RELEASE, "agent");
            asm volatile("s_waitcnt vmcnt(0)" ::: "memory");
            const unsigned og = xb_add(&bar[XB_TOP], 1u);
            const unsigned tg = og / nx;
            if (og + 1u == (tg + 1u) * nx) xb_add(&bar[XB_TOPGEN], 1u);
            else XB_SPIN(xb_ld(&bar[XB_TOPGEN]) == tg, bar);
            __builtin_amdgcn_fence(__ATOMIC_ACQUIRE, "agent");
            xb_add(&bar[XB_XGEN(b.x)], 1u);
            asm volatile("s_waitcnt vmcnt(0)" ::: "memory");
        } else {
            XB_SPIN(xb_ld(&bar[XB_XGEN(b.x)]) == gen, bar);
            __builtin_amdgcn_fence(__ATOMIC_ACQUIRE, "agent");
            asm volatile("s_waitcnt vmcnt(0)" ::: "memory");
        }
    }
    __syncthreads();
}

typedef float f32x16 __attribute__((ext_vector_type(16)));
typedef unsigned v2u __attribute__((ext_vector_type(2)));
typedef short s16x4 __attribute__((ext_vector_type(4)));
typedef unsigned short u16;
struct Args { const float* in[NIN]; float* out; unsigned char* ws; };
struct Frame {
    LAS unsigned char* lds; volatile LAS unsigned* MISC; gu32* ctl;
    int tid, lane, wave, G, vcu;
    unsigned char* ws; float* out;
};
__device__ __forceinline__ float wave_sum(float v) {
#pragma unroll
    for (int o = 1; o < 64; o <<= 1) v += __shfl_xor(v, o);
    return v;
}
__device__ __forceinline__ const float* argp(int k) { const __attribute__((address_space(4))) char* p = (const __attribute__((address_space(4))) char*)__builtin_amdgcn_kernarg_segment_ptr(); asm volatile("" : "+s"(p)); return *(const float* const __attribute__((address_space(4)))*)(p + 8 * k); }
__device__ __forceinline__ int opaque(int v) { asm volatile("" : "+v"(v)); return v; }
__device__ __forceinline__ float bf2f(unsigned short b) { return __uint_as_float((unsigned)b << 16); }
__device__ __forceinline__ float bflo(unsigned w) { return __uint_as_float(w << 16); }
__device__ __forceinline__ float bfhi(unsigned w) { return __uint_as_float(w & 0xffff0000u); }
__device__ __forceinline__ unsigned cvtpk(float lo, float hi) { unsigned r; asm volatile("v_cvt_pk_bf16_f32 %0, %1, %2" : "=v"(r) : "v"(lo), "v"(hi)); return r; }

template <class CM> __device__ __forceinline__ void tr_item(const float* __restrict__ W, int K, int Nsrc, bf16* WT, int nblk, int item, LAS float* scr, int lane, const CM& colmap) {
    const int kb = item / nblk, nb = item % nblk, k0 = 64 * kb, n0 = 32 * nb;
    const int sc = colmap(n0 + (lane & 31));
#pragma unroll 8
    for (int i = 0; i < 32; ++i) { const int kk = 2 * i + (lane >> 5); scr[kk * 33 + (lane & 31)] = sc >= 0 ? W[(size_t)(k0 + kk) * Nsrc + sc] : 0.f; }
    LDS_WAIT(); asm volatile("" ::: "memory");
    const int c = lane & 7;
#pragma unroll
    for (int j = 0; j < 4; ++j) { const int n = (lane >> 3) + 8 * j; const LAS float* s = scr + (8 * c) * 33 + n;
        v4u o; o.x = pk2(s[0 * 33], s[1 * 33]); o.y = pk2(s[2 * 33], s[3 * 33]); o.z = pk2(s[4 * 33], s[5 * 33]); o.w = pk2(s[6 * 33], s[7 * 33]);
        *(GAS v4u*)(WT + (size_t)(n0 + n) * K + k0 + 8 * c) = o; }
    LDS_WAIT(); asm volatile("" ::: "memory");
}
struct CmIdent { __device__ __forceinline__ int operator()(int n) const { return n; } };
struct CmL0In { __device__ __forceinline__ int operator()(int n) const { const int blk = n >> 9, j = n & 511; const int sb = (blk & 1) * 3 + (blk >> 1); return sb * 512 + j; } };
struct CmL1In { __device__ __forceinline__ int operator()(int n) const {
    if (n < 4096 + 256) { const int j = n & 255, base = n - j; return base + (j < 64 ? (j >> 1) + 32 * (j & 1) : j); }
    if (n < 5376 + 64) { const int jj = n - 4352, j = jj & 63, base = 4352 + (jj - j); return base + (j < 16 ? (j >> 1) + 8 * (j & 1) : j); }
    if (n < 5376 + 80) return 5440 + (n - 5440);
    return -1; } };

__device__ __forceinline__ void p0_row(const float* xrow, bf16* orow, float* lsf, const LAS float* wf, const float* bfv, int lane) {
    const GAS f32x4* xr = (const GAS f32x4*)xrow + lane;
    f32x4 v[4];
#pragma unroll
    for (int j = 0; j < 4; ++j) v[j] = xr[64 * j];
    GAS unsigned long long* o8 = (GAS unsigned long long*)orow + lane;
#pragma unroll
    for (int j = 0; j < 4; ++j) o8[64 * j] = (unsigned long long)pk2(v[j].x, v[j].y) | ((unsigned long long)pk2(v[j].z, v[j].w) << 32);
    float a[8] = {0.f, 0.f, 0.f, 0.f, 0.f, 0.f, 0.f, 0.f};
#pragma unroll
    for (int j = 0; j < 4; ++j)
#pragma unroll
        for (int e = 0; e < 4; ++e) { const int k = 256 * j + 4 * lane + e; const f32x4 w0 = *(const LAS f32x4*)(wf + k * 8), w1 = *(const LAS f32x4*)(wf + k * 8 + 4); const float xv = v[j][e];
            a[0] += xv * w0[0]; a[1] += xv * w0[1]; a[2] += xv * w0[2]; a[3] += xv * w0[3]; a[4] += xv * w1[0]; a[5] += xv * w1[1]; a[6] += xv * w1[2]; a[7] += xv * w1[3]; }
#pragma unroll
    for (int h = 0; h < 8; ++h) a[h] = wave_sum(a[h]);
    float mine = a[0];
#pragma unroll
    for (int h = 1; h < 8; ++h) mine = (lane == h) ? a[h] : mine;
    if (lane < 8) { const float f = mine + bfv[lane]; const float ls = -(fmaxf(-f, 0.f) + log1pf(__expf(-fabsf(f)))); lsf[lane] = ls; }
}
__device__ __forceinline__ void p0_prologue(Frame& F) {
    const int tid_ = opaque(F.tid), lane_ = tid_ & 63;
    LAS float* scr = (LAS float*)(F.lds + RING_OFF + F.wave * 8704);
    LAS float* wf = (LAS float*)(F.lds + RING_OFF + 73728);
    const float* w0in = argp(2);
    for (int i = tid_; i < 1024 * 8; i += NWAVES * 64) wf[i] = w0in[(size_t)(i >> 3) * W_IN_AB + 3072 + (i & 7)];
    __syncthreads();
    const int gw = F.vcu * NWAVES + F.wave, NGW = F.G * NWAVES;
    constexpr int I_IN = 16 * (NQKV0 / 32), I_O = 16 * 32, I_UP = 16 * (FF2 / 32), I_DN = (FF / 64) * 32;
    constexpr int NITEMS = I_IN + I_O + 2 * I_UP + 2 * I_DN;
    bf16* ws16 = (bf16*)F.ws;
    for (int it = gw; it < NITEMS; it += NGW) {
        int r = it;
        if (r < I_IN) { tr_item(argp(2), DM, W_IN_AB, (bf16*)(F.ws + WS_W0IN), NQKV0 / 32, r, scr, lane_, CmL0In()); continue; } r -= I_IN;
        if (r < I_O) { tr_item(argp(4), DM, DM, (bf16*)(F.ws + WS_W0O), 32, r, scr, lane_, CmIdent()); continue; } r -= I_O;
        if (r < I_UP) { tr_item(argp(7), DM, FF2, (bf16*)(F.ws + WS_W0UP), FF2 / 32, r, scr, lane_, CmIdent()); continue; } r -= I_UP;
        if (r < I_DN) { tr_item(argp(10), FF, DM, (bf16*)(F.ws + WS_W0DN), 32, r, scr, lane_, CmIdent()); continue; } r -= I_DN;
        if (r < I_UP) { tr_item(argp(18), DM, FF2, (bf16*)(F.ws + WS_W1UP), FF2 / 32, r, scr, lane_, CmIdent()); continue; } r -= I_UP;
        tr_item(argp(21), FF, DM, (bf16*)(F.ws + WS_W1DN), 32, r, scr, lane_, CmIdent());
    }
    (void)ws16;
    const float* x = argp(0); bf16* XB = (bf16*)(F.ws + WS_XB); float* LSF = (float*)(F.ws + WS_LSF);
    for (int m = gw; m < M; m += NGW) p0_row(x + (size_t)m * DM, XB + (size_t)m * DM, LSF + (size_t)m * 8, wf, argp(3), lane_);
}

__device__ __forceinline__ void p1b_scan_kn(Frame& F) {
    const int tid_ = opaque(F.tid), lane_ = tid_ & 63;
    const float* LSF = (const float*)(F.ws + WS_LSF); float* CUM = (float*)(F.ws + WS_CUM);
    if (blockIdx.x < 16) {
        const int b = blockIdx.x >> 3, h = blockIdx.x & 7, t0 = 16 * tid_;
        float v[16]; float s = 0.f;
#pragma unroll
        for (int j = 0; j < 16; ++j) { s += LSF[(size_t)(b * SEQ + t0 + j) * 8 + h]; v[j] = s; }
        float inc = s;
#pragma unroll
        for (int o = 1; o < 64; o <<= 1) { const float u = __shfl_up(inc, o); if (lane_ >= o) inc += u; }
        LAS float* wt = (LAS float*)(F.lds + RING_OFF);
        if (lane_ == 63) wt[F.wave] = inc;
        __syncthreads();
        float off = inc - s;
        for (int w = 0; w < F.wave; ++w) off += wt[w];
#pragma unroll
        for (int j = 0; j < 16; ++j) CUM[(size_t)(b * 8 + h) * SEQ + t0 + j] = off + v[j];
        __syncthreads();
    } else {
        const bf16* KB = (const bf16*)(F.ws + WS_K);
        const int gw = (blockIdx.x - 16) * NWAVES + F.wave, NGW = (F.G - 16) * NWAVES;
        float mx0 = 0.f, mx1 = 0.f;
        for (int m = gw; m < M; m += NGW) {
            const v4u w = *(const GAS v4u*)(KB + (size_t)m * DM + 512 + lane_ * 8);
            float s = bflo(w.x) * bflo(w.x) + bfhi(w.x) * bfhi(w.x) + bflo(w.y) * bflo(w.y) + bfhi(w.y) * bfhi(w.y) + bflo(w.z) * bflo(w.z) + bfhi(w.z) * bfhi(w.z) + bflo(w.w) * bflo(w.w) + bfhi(w.w) * bfhi(w.w);
            s += __shfl_xor(s, 1); s += __shfl_xor(s, 2); s += __shfl_xor(s, 4);
            if (m < SEQ) mx0 = fmaxf(mx0, s); else mx1 = fmaxf(mx1, s);
        }
        if ((lane_ & 7) == 0) { atomicMax((unsigned*)(F.ctl + CW_KN) + (lane_ >> 3), __float_as_uint(mx0)); atomicMax((unsigned*)(F.ctl + CW_KN) + 8 + (lane_ >> 3), __float_as_uint(mx1)); }
    }
}
__device__ __forceinline__ void ln_phase(Frame& F, float* y, const float* g, const float* bta, bf16* xb) {
    const int tid_ = opaque(F.tid), lane_ = tid_ & 63;
    const int gw = F.vcu * NWAVES + F.wave, NGW = F.G * NWAVES;
    f32x4 gv[4], bv[4];
#pragma unroll
    for (int j = 0; j < 4; ++j) { gv[j] = ((const GAS f32x4*)g)[lane_ + 64 * j]; bv[j] = ((const GAS f32x4*)bta)[lane_ + 64 * j]; }
    for (int m = gw; m < M; m += NGW) {
        GAS f32x4* yr = (GAS f32x4*)(y + (size_t)m * DM) + lane_;
        f32x4 v[4]; float s = 0.f;
#pragma unroll
        for (int j = 0; j < 4; ++j) { v[j] = yr[64 * j]; s += (v[j].x + v[j].y) + (v[j].z + v[j].w); }
        const float mean = wave_sum(s) * (1.f / DM); float s2 = 0.f;
#pragma unroll
        for (int j = 0; j < 4; ++j) { v[j] = v[j] - mean; s2 += (v[j].x * v[j].x + v[j].y * v[j].y) + (v[j].z * v[j].z + v[j].w * v[j].w); }
        const float rstd = 1.f / sqrtf(wave_sum(s2) * (1.f / DM) + LN_EPS);
#pragma unroll
        for (int j = 0; j < 4; ++j) { v[j] = v[j] * rstd * gv[j] + bv[j]; yr[64 * j] = v[j]; }
        if (xb) { GAS unsigned long long* o8 = (GAS unsigned long long*)(xb + (size_t)m * DM) + lane_;
#pragma unroll
            for (int j = 0; j < 4; ++j) o8[64 * j] = (unsigned long long)pk2(v[j].x, v[j].y) | ((unsigned long long)pk2(v[j].z, v[j].w) << 32); }
    }
}
__device__ __forceinline__ float gelu_tanh(float x) { const float u = 0.7978845608028654f * (x + 0.044715f * x * x * x); return x / (1.f + __expf(-2.f * u)); }
__device__ __forceinline__ void conv_phase(Frame& F, bf16* H, const float* cw, const float* cb) {
    const int tid_ = opaque(F.tid), lane_ = tid_ & 63; (void)lane_;
    constexpr int NCG = FF / 8, NRUN = M / 16;
    const int gt = F.vcu * (NWAVES * 64) + tid_, NGT = F.G * NWAVES * 64;
    for (int it = gt; it < NCG * NRUN; it += NGT) {
        const int cg = it % NCG, run = it / NCG, c0 = cg * 8, row0 = run * 16;
        float w0[8], w1[8], w2[8], b0[8];
#pragma unroll
        for (int e = 0; e < 8; ++e) { w0[e] = cw[c0 + e]; w1[e] = cw[FF + c0 + e]; w2[e] = cw[2 * FF + c0 + e]; b0[e] = cb[c0 + e]; }
        v4u g2 = (v4u){0u, 0u, 0u, 0u}, g1 = g2;
        if ((row0 & (SEQ - 1)) != 0) { g2 = *(const GAS v4u*)(H + (size_t)(row0 - 2) * FF2 + c0); g1 = *(const GAS v4u*)(H + (size_t)(row0 - 1) * FF2 + c0); }
        for (int j = 0; j < 16; ++j) {
            const size_t off = (size_t)(row0 + j) * FF2 + c0;
            const v4u g0 = *(const GAS v4u*)(H + off), uu = *(const GAS v4u*)(H + off + FF);
            unsigned gg2[4] = {g2.x, g2.y, g2.z, g2.w}, gg1[4] = {g1.x, g1.y, g1.z, g1.w}, gg0[4] = {g0.x, g0.y, g0.z, g0.w}, u4[4] = {uu.x, uu.y, uu.z, uu.w}, o[4];
#pragma unroll
            for (int p = 0; p < 4; ++p) {
                const float ca = b0[2 * p] + w0[2 * p] * bflo(gg2[p]) + w1[2 * p] * bflo(gg1[p]) + w2[2 * p] * bflo(gg0[p]);
                const float cb2 = b0[2 * p + 1] + w0[2 * p + 1] * bfhi(gg2[p]) + w1[2 * p + 1] * bfhi(gg1[p]) + w2[2 * p + 1] * bfhi(gg0[p]);
                o[p] = pk2(gelu_tanh(ca) * bflo(u4[p]), gelu_tanh(cb2) * bfhi(u4[p]));
            }
            *(GAS v4u*)(H + off + FF) = (v4u){o[0], o[1], o[2], o[3]};
            g2 = g1; g1 = g0;
        }
    }
}
__device__ __forceinline__ void p8_prep(Frame& F) {
    const int tid_ = opaque(F.tid), lane_ = tid_ & 63;
    LAS float* scr = (LAS float*)(F.lds + RING_OFF + F.wave * 8704);
    const int gw = F.vcu * NWAVES + F.wave, NGW = F.G * NWAVES;
    constexpr int I_IN1 = 16 * (N1PAD / 32);
    for (int it = gw; it < I_IN1; it += NGW) tr_item(argp(13), DM, W_IN_C, (bf16*)(F.ws + WS_W1IN), N1PAD / 32, it, scr, lane_, CmL1In());
    const int gt = F.vcu * (NWAVES * 64) + tid_, NGT = F.G * NWAVES * 64;
    const float* wuv = argp(14); const float* wo = argp(15); bf16* WcT = (bf16*)(F.ws + WS_WC);
    for (int it = gt; it < 1024 * 384; it += NGT) {
        const int n = it & 1023, hcg = it >> 10, h = hcg / 24, c0 = (hcg % 24) * 8;
        float a[8] = {0.f, 0.f, 0.f, 0.f, 0.f, 0.f, 0.f, 0.f};
        for (int d = 0; d < 64; ++d) { const float w = wo[(size_t)(h * 64 + d) * DM + n];
#pragma unroll
            for (int e = 0; e < 8; ++e) a[e] += wuv[(size_t)(h * 192 + c0 + e) * 64 + d] * w; }
        *(GAS v4u*)(WcT + (size_t)n * 3072 + h * 192 + c0) = (v4u){pk2(a[0], a[1]), pk2(a[2], a[3]), pk2(a[4], a[5]), pk2(a[6], a[7])};
    }
    const int* pos = (const int*)argp(1); float* csq = (float*)(F.ws + WS_CSQ); float* csi = (float*)(F.ws + WS_CSI);
    for (int it = gt; it < M * 40; it += NGT) {
        const int row = it / 40, i = it % 40;
        double fq = 1.0; { const double rr = i < 32 ? 0.6636012376960885 : 0.19392274474868576; const int ii = i < 32 ? i : i - 32; for (int q = 0; q < ii; ++q) fq *= rr; }
        const float ang = (float)pos[row] * (float)fq;
        double rev = (double)ang * 0.15915494309189535; rev -= __builtin_rint(rev);
        const float fr = (float)rev, c = __builtin_amdgcn_cosf(fr), s = __builtin_amdgcn_sinf(fr);
        float* dst = i < 32 ? csq + (size_t)row * 64 + 2 * i : csi + (size_t)row * 16 + 2 * (i - 32);
        dst[0] = c; dst[1] = s;
    }
}
constexpr int A0_K = 0, A0_V = 16384, A0_CK = 32768, A0_FLAG = 33280, A0_WS = 33344;
__device__ __forceinline__ int crow(int r, int hi) { return (r & 3) + 8 * (r >> 2) + 4 * hi; }
__device__ __forceinline__ s16x4 vtr(const LAS unsigned char* p) { return __builtin_bit_cast(s16x4, __builtin_amdgcn_ds_read_tr16_b64_v4i16((LAS s16x4*)p)); }
__device__ __forceinline__ void sb_sub(f32x16& p, int kbase, int tq, int hi, bool needmask, float& R) {
    float ls[16];
#pragma unroll
    for (int r = 0; r < 16; ++r) { const float z = p[r], e = __expf(-fabsf(z)), sp = fmaxf(z, 0.f) + __logf(1.f + e); const bool vis = !needmask || (kbase + crow(r, hi) < tq);
        ls[r] = vis ? -sp : 0.f; p[r] = vis ? (z - sp) : -INFINITY; }
    float T[4], Tp[4];
#pragma unroll
    for (int g = 0; g < 4; ++g) { T[g] = (ls[4 * g] + ls[4 * g + 1]) + (ls[4 * g + 2] + ls[4 * g + 3]); Tp[g] = __shfl_xor(T[g], 32); }
    float E = 0.f;
#pragma unroll
    for (int g = 3; g >= 0; --g) {
        const float a3 = R + E + (hi == 0 ? Tp[g] : 0.f), a2 = a3 + ls[4 * g + 3], a1 = a2 + ls[4 * g + 2], a0 = a1 + ls[4 * g + 1];
        p[4 * g + 3] = __expf(p[4 * g + 3] + a3); p[4 * g + 2] = __expf(p[4 * g + 2] + a2); p[4 * g + 1] = __expf(p[4 * g + 1] + a1); p[4 * g] = __expf(p[4 * g] + a0);
        E += T[g] + Tp[g];
    }
    R += E;
}
template <bool FOX> __device__ __forceinline__ void attn0_unit(Frame& F, int b, int h, int qb) {
    LAS unsigned char* L = F.lds + RING_OFF;
    const int tid = opaque(F.tid), lane = tid & 63, wave = F.wave, r32 = lane & 31, hi = lane >> 5;
    const bf16* Qg = (const bf16*)(F.ws + WS_QO); const bf16* Kg = (const bf16*)(F.ws + WS_K); const bf16* Vg = (const bf16*)(F.ws + WS_V); bf16* Og = (bf16*)(F.ws + WS_XB);
    const float* CUM = (const float*)(F.ws + WS_CUM) + (size_t)(b * 8 + (h & 7)) * SEQ;
    const size_t rowbase = (size_t)b * SEQ; const int q0 = qb * 256, qmin = q0 + wave * 32, qmax = qmin + 31, tq = qmin + r32;
    bf16x8 qf[4];
#pragma unroll
    for (int ks = 0; ks < 4; ++ks) qf[ks] = *(const GAS bf16x8*)(Qg + (rowbase + tq) * DM + h * 64 + 16 * ks + 8 * hi);
    float cq = 0.f, qn = 0.f, knmax = 0.f;
    if (FOX) { cq = CUM[tq]; float s = 0.f;
#pragma unroll
        for (int ks = 0; ks < 4; ++ks)
#pragma unroll
            for (int j = 0; j < 8; ++j) { const float v = bf2f((unsigned short)qf[ks][j]); s += v * v; }
        s += __shfl_xor(s, 32); qn = sqrtf(s); knmax = sqrtf(__uint_as_float(__hip_atomic_load(F.ctl + CW_KN + b * 8 + (h & 7), RLX_AGENT))); }
    f32x16 o0, o1;
#pragma unroll
    for (int r = 0; r < 16; ++r) { o0[r] = 0.f; o1[r] = 0.f; }
    float mrun = -INFINITY, lrun = 0.f, R = 0.f; bool wdone = false;
    const int kt_hi = qb * 4 + 3;
    const int skey = tid >> 3, sch = tid & 7;
    const size_t goff = (rowbase + skey) * DM + h * 64 + sch * 8;
    const int kdst = A0_K + skey * 128 + ((sch ^ (skey & 7)) * 16);
    const int vdst = A0_V + skey * 128 + (((sch >> 2) ^ ((skey >> 1) & 1)) * 64) + (sch & 3) * 16;
    LAS float* wsf = (LAS float*)(L + A0_WS) + wave * 32;
    {   const v4u kreg = *(const GAS v4u*)(Kg + goff + (size_t)kt_hi * 64 * DM), vreg = *(const GAS v4u*)(Vg + goff + (size_t)kt_hi * 64 * DM);
        *(LAS v4u*)(L + kdst) = kreg; *(LAS v4u*)(L + vdst) = vreg;
        if (FOX && tid < 64) ((LAS float*)(L + A0_CK))[tid] = CUM[kt_hi * 64 + tid]; }
    __syncthreads();
    int buf = 0;
    for (int kt = kt_hi; ; --kt) {
        const bool more = kt > 0; const int k0 = kt * 64;
        v4u kreg = (v4u){0u, 0u, 0u, 0u}, vreg = kreg; float ckreg = 0.f;
        if (more) { kreg = *(const GAS v4u*)(Kg + goff + (size_t)(kt - 1) * 64 * DM); vreg = *(const GAS v4u*)(Vg + goff + (size_t)(kt - 1) * 64 * DM); if (FOX && tid < 64) ckreg = CUM[(kt - 1) * 64 + tid]; }
        const bool active = !wdone && (k0 <= qmax);
        if (active) {
            const bool needmask = (k0 + 63 >= qmin);
            const LAS unsigned char* Kb = L + A0_K + buf * 8192; const LAS unsigned char* Vb = L + A0_V + buf * 8192;
            f32x16 p0, p1;
#pragma unroll
            for (int r = 0; r < 16; ++r) { p0[r] = 0.f; p1[r] = 0.f; }
#pragma unroll
            for (int ks = 0; ks < 4; ++ks) { const int ch = ((2 * ks + hi) ^ (r32 & 7)) * 16;
                const bf16x8 a0 = *(const LAS bf16x8*)(Kb + r32 * 128 + ch), a1 = *(const LAS bf16x8*)(Kb + (32 + r32) * 128 + ch);
                p0 = __builtin_amdgcn_mfma_f32_32x32x16_bf16(a0, qf[ks], p0, 0, 0, 0); p1 = __builtin_amdgcn_mfma_f32_32x32x16_bf16(a1, qf[ks], p1, 0, 0, 0); }
            if (FOX) {
                const LAS float* ckb = (const LAS float*)(L + A0_CK) + buf * 64;
#pragma unroll
                for (int g = 0; g < 4; ++g) { const f32x4 c0v = *(const LAS f32x4*)(ckb + 8 * g + 4 * hi), c1v = *(const LAS f32x4*)(ckb + 32 + 8 * g + 4 * hi);
#pragma unroll
                    for (int i = 0; i < 4; ++i) { p0[4 * g + i] += cq - c0v[i]; p1[4 * g + i] += cq - c1v[i]; } }
                if (needmask) {
#pragma unroll
                    for (int r = 0; r < 16; ++r) { const int key = k0 + crow(r, hi); if (key > tq) p0[r] = -INFINITY; if (key + 32 > tq) p1[r] = -INFINITY; } }
                float rm = fmaxf(p0[0], p1[0]);
#pragma unroll
                for (int r = 1; r < 16; ++r) rm = fmaxf(rm, fmaxf(p0[r], p1[r]));
                rm = fmaxf(rm, __shfl_xor(rm, 32));
                const float mnew = fmaxf(mrun, rm), alpha = __expf(mrun - mnew);
                float ps = 0.f;
#pragma unroll
                for (int r = 0; r < 16; ++r) { p0[r] = __expf(p0[r] - mnew); p1[r] = __expf(p1[r] - mnew); ps += p0[r] + p1[r]; }
                lrun = lrun * alpha + ps; mrun = mnew;
                if (__any(alpha != 1.f)) {
                    if (hi == 0) wsf[r32] = alpha;
                    __builtin_amdgcn_wave_barrier();
#pragma unroll
                    for (int r = 0; r < 16; ++r) { const float f = wsf[crow(r, hi)]; o0[r] *= f; o1[r] *= f; }
                    __builtin_amdgcn_wave_barrier();
                }
            } else {
                sb_sub(p1, k0 + 32, tq, hi, needmask, R);
                sb_sub(p0, k0, tq, hi, needmask, R);
            }
            const int vlane = ((lane >> 4) & 1) * 32 + (lane & 3) * 8, kq = 4 * hi + ((lane & 15) >> 2);
#pragma unroll
            for (int sub = 0; sub < 2; ++sub)
#pragma unroll
                for (int s = 0; s < 2; ++s) {
                    v4u pw;
                    if (sub == 0) { pw.x = cvtpk(p0[8 * s], p0[8 * s + 1]); pw.y = cvtpk(p0[8 * s + 2], p0[8 * s + 3]); pw.z = cvtpk(p0[8 * s + 4], p0[8 * s + 5]); pw.w = cvtpk(p0[8 * s + 6], p0[8 * s + 7]); }
                    else { pw.x = cvtpk(p1[8 * s], p1[8 * s + 1]); pw.y = cvtpk(p1[8 * s + 2], p1[8 * s + 3]); pw.z = cvtpk(p1[8 * s + 4], p1[8 * s + 5]); pw.w = cvtpk(p1[8 * s + 6], p1[8 * s + 7]); }
                    const bf16x8 pa = __builtin_bit_cast(bf16x8, pw);
                    const int key0 = 32 * sub + 16 * s + kq, sw = (key0 >> 1) & 1;
#pragma unroll
                    for (int db = 0; db < 2; ++db) {
                        const LAS unsigned char* va = Vb + key0 * 128 + ((db ^ sw) * 64) + vlane;
                        const s16x4 lo = vtr(va), hh = vtr(va + 8 * 128);
                        const bf16x8 vf = (bf16x8){lo[0], lo[1], lo[2], lo[3], hh[0], hh[1], hh[2], hh[3]};
                        if (db == 0) o0 = __builtin_amdgcn_mfma_f32_32x32x16_bf16(pa, vf, o0, 0, 0, 0); else o1 = __builtin_amdgcn_mfma_f32_32x32x16_bf16(pa, vf, o1, 0, 0, 0);
                    }
                }
        }
        if (!wdone) {
            if (!more) wdone = true;
            else if (FOX) { const float bound = qn * knmax + cq - CUM[k0 - 1]; wdone = __all(bound < mrun - 30.f); }
            else wdone = __all(R < -30.f);
        }
        LAS unsigned* flg = (LAS unsigned*)(L + A0_FLAG) + (kt & 1) * 8;
        if (lane == 0) flg[wave] = wdone ? 1u : 0u;
        if (more) { const int o = (buf ^ 1) * 8192; *(LAS v4u*)(L + kdst + o) = kreg; *(LAS v4u*)(L + vdst + o) = vreg; if (FOX && tid < 64) ((LAS float*)(L + A0_CK))[(buf ^ 1) * 64 + tid] = ckreg; }
        __syncthreads();
        if (!more) break;
        unsigned alld = 1u;
#pragma unroll
        for (int w = 0; w < 8; ++w) alld &= flg[w];
        if (alld) break;
        buf ^= 1;
    }
    float inv = 1.f;
    if (FOX) { const float lt = lrun + __shfl_xor(lrun, 32); inv = 1.f / lt; }
    if (hi == 0) wsf[r32] = inv;
    __builtin_amdgcn_wave_barrier();
#pragma unroll
    for (int r = 0; r < 16; ++r) { const float f = wsf[crow(r, hi)]; bf16* op = Og + (rowbase + qmin + crow(r, hi)) * DM + h * 64 + r32;
        op[0] = (bf16)f2bf(o0[r] * f); op[32] = (bf16)f2bf(o1[r] * f); }
    __syncthreads();
}
__device__ __forceinline__ void p2_attention(Frame& F) {
    for (int u = F.vcu; u < 512; u += F.G) attn0_unit<true>(F, u >> 8, 8 + ((u >> 5) & 7), u & 31);
    for (int u = F.vcu; u < 512; u += F.G) attn0_unit<false>(F, u >> 8, (u >> 5) & 7, u & 31);
}
constexpr int IX_CAP = 1024, IX_TRIG = IX_CAP - 256;
constexpr int IX_QS = 0, IX_SC = 36864, IX_ID = IX_SC + 16 * IX_CAP * 4, IX_CNT = IX_ID + 16 * IX_CAP * 2, IX_TAU = IX_CNT + 64;
static_assert(IX_TAU + 64 <= RING_BYTES, "indexer LDS");
__device__ __forceinline__ unsigned mono_key(float f) { const unsigned u = __float_as_uint(f); return (u & 0x80000000u) ? ~u : (u | 0x80000000u); }
__device__ __forceinline__ float mono_inv(unsigned k) { return __uint_as_float((k & 0x80000000u) ? (k & 0x7fffffffu) : ~k); }
__device__ __forceinline__ int wave_sum_dpp(int v) {
    v += __builtin_amdgcn_update_dpp(0, v, 0xB1, 0xF, 0xF, false);
    v += __builtin_amdgcn_update_dpp(0, v, 0x4E, 0xF, 0xF, false);
    v += __builtin_amdgcn_update_dpp(0, v, 0x141, 0xF, 0xF, false);
    v += __builtin_amdgcn_update_dpp(0, v, 0x140, 0xF, 0xF, false);
    return __builtin_amdgcn_readlane(v, 0) + __builtin_amdgcn_readlane(v, 16) + __builtin_amdgcn_readlane(v, 32) + __builtin_amdgcn_readlane(v, 48);
}
__device__ __forceinline__ float select256(LAS float* sc, LAS u16* id, int n, int lane_, bool exact, int* cnt_out) {
    constexpr int NE = IX_CAP / 64;
    const int lane = opaque(lane_), nl = n - lane;
    unsigned key[NE]; u16 idv[NE];
#pragma unroll
    for (int j = 0; j < NE; ++j) { const bool valid = 64 * j < nl; key[j] = valid ? mono_key(sc[lane + 64 * j]) : 0u; idv[j] = valid ? id[lane + 64 * j] : (u16)0; }
    unsigned T = 0u; int cntT = n; bool full = true;
#pragma unroll 1
    for (int bit = 31; bit >= 0; --bit) {
        const unsigned cand = T | (1u << bit); int tot = 0;
        unsigned long long mk[NE];
#pragma unroll
        for (int j = 0; j < NE; ++j) asm volatile("v_cmp_le_u32 %0, %1, %2" : "=s"(mk[j]) : "s"(cand), "v"(key[j]));
#pragma unroll
        for (int j = 0; j < NE; ++j) tot += __popcll(mk[j]);
        if (tot >= 256) { T = cand; cntT = tot; }
        if (!exact && bit <= 16 && bit > 0 && cntT <= 384 && T > 1u) { full = false; break; }
    }
    const unsigned Te = full ? T : T - 1u;
    int cg = 0, ce = 0;
#pragma unroll
    for (int j = 0; j < NE; ++j) { cg += (key[j] > Te) ? 1 : 0; ce += (key[j] == Te) ? 1 : 0; }
    int pk = cg | (ce << 16), inc = pk;
#pragma unroll
    for (int o = 1; o < 64; o <<= 1) { const int u = __shfl_up(inc, o); if (lane >= o) inc += u; }
    const int totp = __builtin_amdgcn_readlane(inc, 63), above = totp & 0xffff;
    const int kk = full ? 256 - above : 0;
    int pg = (inc - pk) & 0xffff, pe = (inc - pk) >> 16;
#pragma unroll
    for (int j = 0; j < NE; ++j) {
        const bool gt = key[j] > Te, eq = (key[j] == Te) && (pe < kk);
        if (gt) { sc[pg] = mono_inv(key[j]); id[pg] = idv[j]; }
        if (eq) { sc[above + pe] = mono_inv(key[j]); id[above + pe] = idv[j]; }
        pg += gt ? 1 : 0; pe += (key[j] == Te) ? 1 : 0;
    }
    *cnt_out = above + (kk > 0 ? kk : 0);
    return mono_inv(Te);
}
__device__ __forceinline__ void idx_unit(Frame& F, int b, int qg) {
    LAS unsigned char* L = F.lds + RING_OFF;
    const int tid = opaque(F.tid), lane = tid & 63, wave = F.wave, r32 = lane & 31, hi = lane >> 5, q = lane & 15, hsel = (lane >> 4) & 1;
    const size_t rowbase = (size_t)b * SEQ; const int t0 = qg * 16, nvis = ((t0 >> 6) + 1) * 64;
    const bf16* QI = (const bf16*)(F.ws + WS_QI); const bf16* KI = (const bf16*)(F.ws + WS_KI); const float* WI = (const float*)(F.ws + WS_WI); u16* IDX = (u16*)(F.ws + WS_IDX);
    LAS float* SC = (LAS float*)(L + IX_SC); LAS u16* ID = (LAS u16*)(L + IX_ID); LAS unsigned* CNT = (LAS unsigned*)(L + IX_CNT); LAS float* TAU = (LAS float*)(L + IX_TAU);
#pragma unroll
    for (int i = 0; i < 4; ++i) { const int ci = tid + 512 * i, qq = ci >> 7, rem = ci & 127, hh = rem >> 3, ch = rem & 7;
        *(LAS v4u*)(L + IX_QS + (hh * 16 + qq) * 144 + ch * 16) = *(const GAS v4u*)(QI + (rowbase + t0 + qq) * 1024 + hh * 64 + ch * 8); }
    if (tid < 16) { CNT[tid] = 0u; TAU[tid] = -INFINITY; }
    float wv[8];
#pragma unroll
    for (int hp = 0; hp < 8; ++hp) wv[hp] = WI[(rowbase + t0 + q) * 16 + 2 * hp + hsel];
    __syncthreads();
    bf16x8 afn[4];
#pragma unroll
    for (int ks = 0; ks < 4; ++ks) afn[ks] = *(const GAS bf16x8*)(KI + (rowbase + wave * 32 + r32) * 64 + 16 * ks + 8 * hi);
    for (int r0 = 0; r0 < nvis; r0 += 256) {
        const int kbase = r0 + wave * 32;
        bf16x8 af[4];
#pragma unroll
        for (int ks = 0; ks < 4; ++ks) af[ks] = afn[ks];
        if (kbase + 256 < nvis) {
#pragma unroll
            for (int ks = 0; ks < 4; ++ks) afn[ks] = *(const GAS bf16x8*)(KI + (rowbase + kbase + 256 + r32) * 64 + 16 * ks + 8 * hi); }
        if (kbase < nvis) {
            f32x16 acc;
#pragma unroll
            for (int r = 0; r < 16; ++r) acc[r] = 0.f;
#pragma unroll
            for (int hp = 0; hp < 8; hp += 2) {
                f32x16 c0, c1;
#pragma unroll
                for (int r = 0; r < 16; ++r) { c0[r] = 0.f; c1[r] = 0.f; }
                const LAS unsigned char* q0p = L + IX_QS + ((2 * hp + hsel) * 16 + q) * 144 + hi * 16;
                const LAS unsigned char* q1p = q0p + 2 * 16 * 144;
#pragma unroll
                for (int ks = 0; ks < 4; ++ks) { const bf16x8 b0 = *(const LAS bf16x8*)(q0p + ks * 32), b1 = *(const LAS bf16x8*)(q1p + ks * 32);
                    c0 = __builtin_amdgcn_mfma_f32_32x32x16_bf16(af[ks], b0, c0, 0, 0, 0); c1 = __builtin_amdgcn_mfma_f32_32x32x16_bf16(af[ks], b1, c1, 0, 0, 0); }
#pragma unroll
                for (int r = 0; r < 16; ++r) { const int i0 = __float_as_int(c0[r]), i1 = __float_as_int(c1[r]); const float y0 = __int_as_float(i0 > 0 ? i0 : 0), y1 = __int_as_float(i1 > 0 ? i1 : 0); acc[r] += wv[hp] * y0; acc[r] += wv[hp + 1] * y1; }
                __builtin_amdgcn_sched_barrier(0);
            }
#pragma unroll
            for (int r = 0; r < 16; ++r) acc[r] += __shfl_xor(acc[r], 16);
            const float tau = TAU[q];
            float sv[8]; int np = 0;
#pragma unroll
            for (int j = 0; j < 8; ++j) { sv[j] = hsel ? acc[8 + j] : acc[j]; np += (sv[j] > tau) ? 1 : 0; }
            if (np > 0) {
                unsigned pos = atomicAdd((unsigned*)(CNT + q), (unsigned)np);
                const int kb0 = kbase + 16 * hsel + 4 * hi;
#pragma unroll
                for (int j = 0; j < 8; ++j) if (sv[j] > tau) { SC[q * IX_CAP + pos] = sv[j]; ID[q * IX_CAP + pos] = (u16)(kb0 + (j & 3) + 8 * (j >> 2)); ++pos; }
            }
        }
        __syncthreads();
        unsigned mx = CNT[lane & 15];
#pragma unroll
        for (int o = 1; o < 16; o <<= 1) { const unsigned u = (unsigned)__shfl_xor((int)mx, o); mx = u > mx ? u : mx; }
        const bool last = r0 + 256 >= nvis;
        if (mx > (unsigned)IX_TRIG || last) {
#pragma unroll 1
            for (int qq = 2 * wave; qq < 2 * wave + 2; ++qq) { const int n = (int)CNT[qq];
                if (n > 256) { int nc; const float t = select256(SC + qq * IX_CAP, ID + qq * IX_CAP, n, lane, last, &nc); if (lane == 0) { CNT[qq] = (unsigned)nc; TAU[qq] = t; } } } }
        __syncthreads();
    }
    { const int qq = tid >> 5, n = (int)CNT[qq];
#pragma unroll
      for (int j = 0; j < 8; ++j) { const int i = (tid & 31) + 32 * j; IDX[(rowbase + t0 + qq) * 256 + i] = i < n ? ID[qq * IX_CAP + i] : (u16)0xFFFF; } }
    __syncthreads();
}
__device__ __forceinline__ void p10_indexer(Frame& F) {
    for (int i = 0; i < 1024; i += F.G) {
        const int s = i + F.vcu; if (s >= 1024) break;
        const int j = s >> 8, c = s & 255;
        const int v = (j == 0) ? c : (j == 1) ? 511 - c : (j == 2) ? 512 + c : 1023 - c;
        idx_unit(F, v & 1, v >> 1);
    }
}
constexpr int SP_ROWB = 544, SP_WAVE_BYTES = 32 * SP_ROWB;
static_assert(NWAVES * SP_WAVE_BYTES <= RING_BYTES, "sparse attention LDS");
__device__ __forceinline__ void sparse_query(Frame& F, int row) {
    const int lane = opaque(F.lane), r16 = lane & 15, g = lane >> 4, b = row >> 13, row8 = lane >> 3, p8 = lane & 7;
    LAS unsigned char* vb = F.lds + RING_OFF + F.wave * SP_WAVE_BYTES;
    const u16* ix = (const u16*)(F.ws + WS_IDX) + (size_t)row * 256;
    bf16* qrow = (bf16*)(F.ws + WS_QD) + (size_t)row * 4096;
    const bf16* KL = (const bf16*)(F.ws + WS_KL) + (size_t)b * SEQ * 256;
    bf16x8 qf[8];
#pragma unroll
    for (int ks = 0; ks < 8; ++ks) qf[ks] = *(const GAS bf16x8*)(qrow + r16 * 256 + 32 * ks + 8 * g);
    f32x4 ctx[12];
#pragma unroll
    for (int ct = 0; ct < 12; ++ct) ctx[ct] = (f32x4){0.f, 0.f, 0.f, 0.f};
    float mrun = -INFINITY, lrun = 0.f;
    const int trd = (4 * g + (r16 >> 2)) * SP_ROWB + 128 + (r16 & 3) * 8;
    v4u gr[4][4];
#define SP_GATHER(s_) do { _Pragma("unroll") for (int i_ = 0; i_ < 4; ++i_) { const unsigned key_ = ix[32 * (s_) + 8 * i_ + row8]; \
        const bf16* kp_ = KL + (size_t)(key_ == 0xFFFFu ? 0u : key_) * 256 + 8 * p8; \
        _Pragma("unroll") for (int c_ = 0; c_ < 4; ++c_) gr[i_][c_] = *(const GAS v4u*)(kp_ + 64 * c_); } } while (0)
    SP_GATHER(0);
#pragma unroll 1
    for (int s = 0; s < 8; ++s) {
#pragma unroll
        for (int i = 0; i < 4; ++i)
#pragma unroll
            for (int c = 0; c < 4; ++c) *(LAS v4u*)(vb + (8 * i + row8) * SP_ROWB + c * 128 + p8 * 16) = gr[i][c];
        if (s < 7) SP_GATHER(s + 1);
        f32x4 S0 = (f32x4){0.f, 0.f, 0.f, 0.f}, S1 = S0;
#pragma unroll
        for (int ks = 0; ks < 8; ++ks) {
            const bf16x8 a0 = *(const LAS bf16x8*)(vb + r16 * SP_ROWB + (32 * ks + 8 * g) * 2), a1 = *(const LAS bf16x8*)(vb + (16 + r16) * SP_ROWB + (32 * ks + 8 * g) * 2);
            S0 = __builtin_amdgcn_mfma_f32_16x16x32_bf16(a0, qf[ks], S0, 0, 0, 0); S1 = __builtin_amdgcn_mfma_f32_16x16x32_bf16(a1, qf[ks], S1, 0, 0, 0);
        }
        const v2u i0 = *(const GAS v2u*)(ix + 32 * s + 4 * g), i1 = *(const GAS v2u*)(ix + 32 * s + 16 + 4 * g);
        float x[8];
        x[0] = (i0.x & 0xffffu) == 0xffffu ? -INFINITY : S0[0] * DSA_SCALE; x[1] = (i0.x >> 16) == 0xffffu ? -INFINITY : S0[1] * DSA_SCALE;
        x[2] = (i0.y & 0xffffu) == 0xffffu ? -INFINITY : S0[2] * DSA_SCALE; x[3] = (i0.y >> 16) == 0xffffu ? -INFINITY : S0[3] * DSA_SCALE;
        x[4] = (i1.x & 0xffffu) == 0xffffu ? -INFINITY : S1[0] * DSA_SCALE; x[5] = (i1.x >> 16) == 0xffffu ? -INFINITY : S1[1] * DSA_SCALE;
        x[6] = (i1.y & 0xffffu) == 0xffffu ? -INFINITY : S1[2] * DSA_SCALE; x[7] = (i1.y >> 16) == 0xffffu ? -INFINITY : S1[3] * DSA_SCALE;
        float cm = fmaxf(fmaxf(fmaxf(x[0], x[1]), fmaxf(x[2], x[3])), fmaxf(fmaxf(x[4], x[5]), fmaxf(x[6], x[7])));
        cm = fmaxf(cm, __shfl_xor(cm, 16)); cm = fmaxf(cm, __shfl_xor(cm, 32));
        const float mnew = fmaxf(mrun, cm), alpha = __expf(mrun - mnew);
        float ps = 0.f;
#pragma unroll
        for (int i = 0; i < 8; ++i) { x[i] = __expf(x[i] - mnew); ps += x[i]; }
        lrun = lrun * alpha + ps; mrun = mnew;
        if (__any(alpha != 1.f)) {
#pragma unroll
            for (int ct = 0; ct < 12; ++ct) ctx[ct] = ctx[ct] * alpha; }
        const v4u pw = (v4u){cvtpk(x[0], x[1]), cvtpk(x[2], x[3]), cvtpk(x[4], x[5]), cvtpk(x[6], x[7])};
        const bf16x8 pf = __builtin_bit_cast(bf16x8, pw);
#pragma unroll
        for (int ct = 0; ct < 12; ++ct) {
            const s16x4 lo = vtr(vb + trd + ct * 32), hh = vtr(vb + trd + 16 * SP_ROWB + ct * 32);
            const bf16x8 vf = (bf16x8){lo[0], lo[1], lo[2], lo[3], hh[0], hh[1], hh[2], hh[3]};
            ctx[ct] = __builtin_amdgcn_mfma_f32_16x16x32_bf16(vf, pf, ctx[ct], 0, 0, 0);
        }
    }
#undef SP_GATHER
    lrun += __shfl_xor(lrun, 16); lrun += __shfl_xor(lrun, 32);
    const float inv = 1.f / lrun;
#pragma unroll
    for (int ct = 0; ct < 12; ++ct) { const f32x4 v = ctx[ct] * inv; *(GAS v2u*)(qrow + r16 * 192 + 16 * ct + 4 * g) = (v2u){cvtpk(v[0], v[1]), cvtpk(v[2], v[3])}; }
}
__device__ __forceinline__ void p11_sparse(Frame& F) {
    const int gw = F.vcu * NWAVES + F.wave, NGW = F.G * NWAVES;
    for (int row = gw; row < M; row += NGW) sparse_query(F, row);
}
constexpr int REP_P0 = 1, REP_P2 = 1, REP_P10 = 1;
__global__ void __launch_bounds__(NWAVES * 64, 2) mk_fwd(Args args) {
    extern __shared__ __attribute__((aligned(16))) unsigned char lds[];
    Frame F;
    F.lds = (LAS unsigned char*)lds;
    F.MISC = (volatile LAS unsigned*)(F.lds + MISC_OFF);
    F.tid = threadIdx.x; F.lane = F.tid & 63; F.wave = __builtin_amdgcn_readfirstlane(F.tid >> 6);
    F.G = gridDim.x; { const int bx = blockIdx.x; F.vcu = (F.G % 8 == 0) ? (bx % 8) * (F.G / 8) + bx / 8 : bx; }
    F.ws = args.ws; F.out = args.out; F.ctl = (gu32*)(args.ws + WS_CTL);
    for (int u = F.tid; u < (LDS_BYTES - LDSCTL_OFF) / 4; u += NWAVES * 64) ((LAS unsigned*)(F.lds + LDSCTL_OFF))[u] = 0u;
    __syncthreads();
    XcdBarrier bar = xcd_barrier_post((unsigned*)(F.ctl + CW_BAR), F.MISC + 8);
#define GRID_BAR() xcd_barrier(bar)
    unsigned char* ws = args.ws;
    bf16* XB = (bf16*)(ws + WS_XB); bf16* HB = (bf16*)(ws + WS_H);
    const int bx = (int)blockIdx.x;

    for (int rep = 0; rep < REP_P0; ++rep) p0_prologue(F);
    GRID_BAR();
    {   pg8::Gemm g{XB, (const bf16*)(ws + WS_W0IN), M, NQKV0, DM, DM}; pg8::StaticOrder S; S.init(M, NQKV0, F.G, bx);
        pg8::EpiBf16<0> E{(bf16*)(ws + WS_QO), DM, nullptr, DM, (size_t)(WS_K - WS_QO) / 2, 0.125f};
        pg8::gemm_phase<pg8::EpiBf16<0>, pg8::StaticOrder, PG8_ALIGN, PG8_SP2>(F.lds + RING_OFF, g, S, E); }
    GRID_BAR();
    p1b_scan_kn(F);
    GRID_BAR();
    for (int rep = 0; rep < REP_P2; ++rep) p2_attention(F);
    GRID_BAR();
    {   pg8::Gemm g{XB, (const bf16*)(ws + WS_W0O), M, DM, DM, DM}; pg8::StaticOrder S; S.init(M, DM, F.G, bx);
        pg8::EpiResF32 E{argp(0), F.out, DM, ALPHA};
        pg8::gemm_phase<pg8::EpiResF32, pg8::StaticOrder, PG8_ALIGN, PG8_SP2>(F.lds + RING_OFF, g, S, E); }
    GRID_BAR();
    ln_phase(F, F.out, argp(5), argp(6), XB);
    GRID_BAR();
    {   pg8::Gemm g{XB, (const bf16*)(ws + WS_W0UP), M, FF2, DM, DM}; pg8::StaticOrder S; S.init(M, FF2, F.G, bx);
        pg8::EpiBf16<0> E{HB, FF2, nullptr, 0, 0, 1.f};
        pg8::gemm_phase<pg8::EpiBf16<0>, pg8::StaticOrder, PG8_ALIGN, PG8_SP2>(F.lds + RING_OFF, g, S, E); }
    GRID_BAR();
    conv_phase(F, HB, argp(8), argp(9));
    GRID_BAR();
    {   pg8::Gemm g{HB + FF, (const bf16*)(ws + WS_W0DN), M, DM, FF, FF2}; pg8::StaticOrder S; S.init(M, DM, F.G, bx);
        pg8::EpiResF32 E{F.out, F.out, DM, ALPHA};
        pg8::gemm_phase<pg8::EpiResF32, pg8::StaticOrder, PG8_ALIGN, PG8_SP2>(F.lds + RING_OFF, g, S, E); }
    GRID_BAR();
    ln_phase(F, F.out, argp(11), argp(12), XB);
    p8_prep(F);
    GRID_BAR();
    {   pg8::Gemm g{XB, (const bf16*)(ws + WS_W1IN), M, N1PAD, DM, DM}; pg8::StaticOrder S; S.init(M, N1PAD, F.G, bx);
        pg8::EpiL1In E{(bf16*)(ws + WS_QD), (bf16*)(ws + WS_KL), (bf16*)(ws + WS_QI), (bf16*)(ws + WS_KI), (float*)(ws + WS_WI), (const float*)(ws + WS_CSQ), (const float*)(ws + WS_CSI), IDX_SCALE};
        pg8::gemm_phase<pg8::EpiL1In, pg8::StaticOrder, PG8_ALIGN, PG8_SP2>(F.lds + RING_OFF, g, S, E); }
    GRID_BAR();
    for (int rep = 0; rep < REP_P10; ++rep) p10_indexer(F);
    GRID_BAR();
    p11_sparse(F);
    GRID_BAR();
    {   pg8::Gemm g{(const bf16*)(ws + WS_QD), (const bf16*)(ws + WS_WC), M, DM, 3072, 4096}; pg8::StaticOrder S; S.init(M, DM, F.G, bx);
        pg8::EpiResF32 E{F.out, F.out, DM, ALPHA};
        pg8::gemm_phase<pg8::EpiResF32, pg8::StaticOrder, PG8_ALIGN, PG8_SP2>(F.lds + RING_OFF, g, S, E); }
    GRID_BAR();
    ln_phase(F, F.out, argp(16), argp(17), XB);
    GRID_BAR();
    {   pg8::Gemm g{XB, (const bf16*)(ws + WS_W1UP), M, FF2, DM, DM}; pg8::StaticOrder S; S.init(M, FF2, F.G, bx);
        pg8::EpiBf16<0> E{HB, FF2, nullptr, 0, 0, 1.f};
        pg8::gemm_phase<pg8::EpiBf16<0>, pg8::StaticOrder, PG8_ALIGN, PG8_SP2>(F.lds + RING_OFF, g, S, E); }
    GRID_BAR();
    conv_phase(F, HB, argp(19), argp(20));
    GRID_BAR();
    {   pg8::Gemm g{HB + FF, (const bf16*)(ws + WS_W1DN), M, DM, FF, FF2}; pg8::StaticOrder S; S.init(M, DM, F.G, bx);
        pg8::EpiResF32 E{F.out, F.out, DM, ALPHA};
        pg8::gemm_phase<pg8::EpiResF32, pg8::StaticOrder, PG8_ALIGN, PG8_SP2>(F.lds + RING_OFF, g, S, E); }
    GRID_BAR();
    ln_phase(F, F.out, argp(22), argp(23), nullptr);
#undef GRID_BAR
}

extern "C" void kernel_launch(void* const* d_in, const int* in_sizes, int n_in, void* d_out, int out_size, void* d_ws, size_t ws_size, hipStream_t stream) {
    static int grid = 0;
    if (grid == 0) {
        if (n_in != NIN || in_sizes[0] != M * DM || out_size != M * DM || ws_size < WS_END) { fprintf(stderr, "kernel_launch: unexpected shapes (n_in %d, in0 %d, out %d, ws %zu); nothing launched\n", n_in, n_in > 0 ? in_sizes[0] : -1, out_size, ws_size); grid = -1; return; }
        int dev = 0, cus = 0, per_cu = 0;
        if (hipGetDevice(&dev) != hipSuccess || hipDeviceGetAttribute(&cus, hipDeviceAttributeMultiprocessorCount, dev) != hipSuccess) { grid = -1; return; }
        if (hipFuncSetAttribute((const void*)mk_fwd, hipFuncAttributeMaxDynamicSharedMemorySize, LDS_BYTES) != hipSuccess) { fprintf(stderr, "kernel_launch: hipFuncSetAttribute failed\n"); grid = -1; return; }
        if (hipOccupancyMaxActiveBlocksPerMultiprocessor(&per_cu, (const void*)mk_fwd, NWAVES * 64, LDS_BYTES) != hipSuccess || per_cu < 1) fprintf(stderr, "kernel_launch: occupancy query reports %d workgroups per CU\n", per_cu);
        (void)hipGetLastError();
        grid = cus;
    }
    if (grid < 0) return;
    if (hipMemsetAsync((char*)d_ws + WS_CTL, 0, CTL_ZERO_BYTES, stream) != hipSuccess) { fprintf(stderr, "kernel_launch: hipMemsetAsync failed\n"); return; }
    Args a{};
    for (int i = 0; i < NIN; ++i) a.in[i] = (const float*)d_in[i];
    a.out = (float*)d_out; a.ws = (unsigned char*)d_ws;
    hipLaunchKernelGGL(mk_fwd, dim3(grid), dim3(NWAVES * 64), LDS_BYTES, stream, a);
    const hipError_t le = hipPeekAtLastError();
    if (le != hipSuccess) fprintf(stderr, "kernel_launch: launch failed: %s\n", hipGetErrorName(le));
}
```

```cpp
#include <hip/hip_runtime.h>
#include <cstdio>
#include <cstdint>
namespace pg8 {
#define PG8_LAS __attribute__((address_space(3)))
typedef unsigned short bf16_t;
typedef short bf16x8 __attribute__((ext_vector_type(8)));
typedef float f32x4 __attribute__((ext_vector_type(4)));
typedef unsigned u32x4 __attribute__((ext_vector_type(4)));
constexpr int BM = 256, BK = 64, HALF = 128, HTB = HALF * BK * 2  , STAGE_BYTES = 8 * HTB, NXCD = 8, WGM = 8;

__host__ __device__ __forceinline__ int lds_byte(int r, int c) { const int st = (r >> 4) * 2 + (c >> 5), rr = r & 15, cc = c & 31, ob = rr * 64 + cc * 2; return st * 1024 + (ob ^ (((ob >> 9) & 1) << 5)); }
__host__ __device__ __forceinline__ void stage_rc(int b, int& R, int& C) { const int st = b / 1024, sb = b % 1024, swz = sb ^ (((sb >> 9) & 1) << 5); R = (st >> 1) * 16 + swz / 64; C = (st & 1) * 32 + (swz % 64) / 2; }
__host__ __device__ __forceinline__ int perm32(int rho) { const int n = rho >> 4, i = rho & 15; return 8 * (i >> 2) + 4 * n + (i & 3); }

struct Unit { int pm, pn; };
struct Gemm { const bf16_t* A; const bf16_t* Bt; int M, N, K, lda; };

struct StaticOrder {
    int nM, nN, nwg, G, c;
    __host__ __device__ void init(int M, int N, int G_, int c_) { nM = M / BM; nN = N / BM; nwg = nM * nN; G = G_; c = c_; }
    __host__ __device__ bool next(int i, Unit& u) const {
        const long L = (long)i * G + c; if (L >= nwg) return false;
        int wgid = (int)L; { const int q = nwg / NXCD, r = nwg % NXCD, xcd = wgid % NXCD, off = wgid / NXCD; wgid = (xcd < r ? xcd * (q + 1) : r * (q + 1) + (xcd - r) * q) + off; }
        const int nig = WGM * nN, gid = wgid / nig, fm = gid * WGM, gsz = (nM - fm) < WGM ? (nM - fm) : WGM;
        u.pm = fm + ((wgid % nig) % gsz); u.pn = (wgid % nig) / gsz; return true;
    }
    __device__ __forceinline__ void a_ready(const Unit&) const {}
    __device__ __forceinline__ void done(const Unit&) const {}
};

__device__ __forceinline__ unsigned cvt_pk_bf16(float lo, float hi) { unsigned r; asm volatile("v_cvt_pk_bf16_f32 %0, %1, %2" : "=v"(r) : "v"(lo), "v"(hi)); return r; }
typedef float f32x2 __attribute__((ext_vector_type(2)));
__device__ __forceinline__ f32x2 gelu_pk(f32x2 v) {
    const f32x2 av = __builtin_elementwise_abs(v), d = av * 0.2316418882f + 1.0f;
    f32x2 t; t.x = __builtin_amdgcn_rcpf(d.x); t.y = __builtin_amdgcn_rcpf(d.y);
    f32x2 q = t * 0.5307027145f + (-0.7265760135f); q = q * t + 0.7107068705f; q = q * t + (-0.142248368f); q = q * t + 0.127414796f; q = q * t;
    const f32x2 s = (v * v) * (-0.72134752044f);
    f32x2 e; e.x = __builtin_amdgcn_exp2f(s.x); e.y = __builtin_amdgcn_exp2f(s.y);
    const f32x2 m = v * (q * e), r = v - m;
    f32x2 o; o.x = v.x < 0.f ? m.x : r.x; o.y = v.y < 0.f ? m.y : r.y; return o;
}

template <int ACT  > struct EpiBf16 {
    static constexpr bool PERM = true, AFTER_DRAIN = false; static_assert(ACT == 0 || ACT == 1, "EpiBf16: ACT is 0 (none) or 1 (gelu_pk)");
    bf16_t* O; int ldc; const float* bias; int split_cols; size_t split_stride; float scale0;
    __device__ __forceinline__ void operator()(const f32x4 (&acc)[2][2][4][2], const Unit& u, int wr, int wc, int fr, int fq) const {
        const int row0 = u.pm * BM + wr * 64 + fr; int colt = u.pn * BM; bf16_t* base = O;
        float sc = 1.f; if (split_cols) { const int t = colt / split_cols; base += (size_t)t * split_stride; colt -= t * split_cols; if (t == 0) sc = scale0; }
        const int col0 = colt + wc * 32 + 8 * fq, bcol0 = u.pn * BM + wc * 32 + 8 * fq;
        f32x4 bv[2][2];
#pragma unroll
        for (int bj = 0; bj < 2; ++bj)
#pragma unroll
            for (int n = 0; n < 2; ++n) bv[bj][n] = bias ? *(const f32x4*)(bias + bcol0 + bj * HALF + 4 * n) : (f32x4){0.f, 0.f, 0.f, 0.f};
#pragma unroll
        for (int ai = 0; ai < 2; ++ai)
#pragma unroll
            for (int m = 0; m < 4; ++m) { bf16_t* rowp = base + (size_t)(row0 + ai * HALF + m * 16) * ldc + col0;
#pragma unroll
                for (int bj = 0; bj < 2; ++bj) { f32x4 v0 = acc[ai][bj][m][0] + bv[bj][0], v1 = acc[ai][bj][m][1] + bv[bj][1];
                    if (ACT == 1) { f32x2 a = gelu_pk((f32x2){v0[0], v0[1]}), b = gelu_pk((f32x2){v0[2], v0[3]}), c = gelu_pk((f32x2){v1[0], v1[1]}), d = gelu_pk((f32x2){v1[2], v1[3]});
                        v0 = (f32x4){a.x, a.y, b.x, b.y}; v1 = (f32x4){c.x, c.y, d.x, d.y}; }
                    v0 = v0 * sc; v1 = v1 * sc; u32x4 w; w.x = cvt_pk_bf16(v0[0], v0[1]); w.y = cvt_pk_bf16(v0[2], v0[3]); w.z = cvt_pk_bf16(v1[0], v1[1]); w.w = cvt_pk_bf16(v1[2], v1[3]);
                    *(u32x4*)(rowp + bj * HALF) = w; } }
    }
};
template <class Epi, class Sched, bool ALIGN_EPI = false, bool SP2 = false>
__device__ __forceinline__ void gemm_phase(PG8_LAS unsigned char* lds, const Gemm g, const Sched& S, const Epi& E) {
    int tid_ = threadIdx.x; asm volatile("" : "+v"(tid_));
    const int tid = tid_, wid = __builtin_amdgcn_readfirstlane(tid >> 6), lane = tid & 63, wr = wid >> 2, wc = wid & 3, fr = lane & 15, fq = lane >> 4;
    const int K = g.K, nt = K / BK;
    unsigned voffA[2], voffB[2];
#pragma unroll
    for (int i = 0; i < 2; ++i) { int R, C; stage_rc(tid * 16 + i * 8192, R, C); const int Rb = Epi::PERM ? ((R & ~31) + perm32(R & 31)) : R;
        voffA[i] = (unsigned)(R * g.lda + C) * 2u; voffB[i] = (unsigned)(Rb * K + C) * 2u; }
    const size_t kstep = (size_t)(BK * 2);
    const size_t hstepB = (size_t)HALF * K * 2, hstepA = (size_t)HALF * g.lda * 2;
    const size_t tstepA = 2 * hstepA, tstepB = 2 * hstepB;
    const unsigned ldsw = (unsigned)wid * 1024u;
    const int aoff = lds_byte(wr * 64 + fr, fq * 8), boff = lds_byte(wc * 32 + fr, fq * 8);
#define PG8_SA(b, h) (((b) * 2 + (h)) * HTB)
#define PG8_SB(b, h) ((4 + (b) * 2 + (h)) * HTB)
#define PG8_STAGE(bufoff, gbase, voff) do { _Pragma("unroll") for (int _i = 0; _i < 2; ++_i) \
        __builtin_amdgcn_global_load_lds((const unsigned*)((const char*)(gbase) + (voff)[_i]), (PG8_LAS unsigned*)(lds + (bufoff) + ldsw + _i * 8192), 16, 0, 0); } while (0)
#define PG8_LDA(dst, b, h) do { _Pragma("unroll") for (int m = 0; m < 4; ++m) _Pragma("unroll") for (int k = 0; k < 2; ++k) dst[m][k] = *(const PG8_LAS bf16x8*)(lds + PG8_SA(b, h) + aoff + m * 2048 + k * 1024); } while (0)
#define PG8_LDB(dst, b, h) do { _Pragma("unroll") for (int n = 0; n < 2; ++n) _Pragma("unroll") for (int k = 0; k < 2; ++k) dst[n][k] = *(const PG8_LAS bf16x8*)(lds + PG8_SB(b, h) + boff + n * 2048 + k * 1024); } while (0)
#define PG8_MMA(ai, bj, At, Bt) do { __builtin_amdgcn_s_setprio(1); _Pragma("unroll") for (int m = 0; m < 4; ++m) _Pragma("unroll") for (int n = 0; n < 2; ++n) _Pragma("unroll") for (int k = 0; k < 2; ++k) \
        acc[ai][bj][m][n] = __builtin_amdgcn_mfma_f32_16x16x32_bf16(Bt[n][k], At[m][k], acc[ai][bj][m][n], 0, 0, 0); __builtin_amdgcn_s_setprio(0); } while (0)
#define PG8_WAIT_V(n) asm volatile("s_waitcnt vmcnt(" #n ")" ::: "memory")
#define PG8_WAIT_L(n) asm volatile("s_waitcnt lgkmcnt(" #n ")" ::: "memory")
#define PG8_BAR __builtin_amdgcn_s_barrier()
#define PG8_SCHED __builtin_amdgcn_sched_barrier(0)
    Unit cur, nxt; int ui = 0;
    if (!S.next(0, cur)) return;
    f32x4 acc[2][2][4][2];
#pragma unroll
    for (int a = 0; a < 2; ++a)
#pragma unroll
        for (int b = 0; b < 2; ++b)
#pragma unroll
            for (int m = 0; m < 4; ++m)
#pragma unroll
                for (int n = 0; n < 2; ++n) acc[a][b][m][n] = (f32x4){0.f, 0.f, 0.f, 0.f};
    bf16x8 At[4][2], B0[2][2], B1[2][2];
    const char* cA = (const char*)g.A + (size_t)cur.pm * tstepA; const char* cB = (const char*)g.Bt + (size_t)cur.pn * tstepB;
    S.a_ready(cur);
    if constexpr (SP2) {
        PG8_STAGE(PG8_SB(0, 0), cB, voffB); PG8_STAGE(PG8_SB(0, 1), cB + hstepB, voffB); PG8_STAGE(PG8_SA(0, 0), cA, voffA); PG8_STAGE(PG8_SA(0, 1), cA + hstepA, voffA);
        if (wr == 1) PG8_BAR;
        PG8_WAIT_V(2); PG8_BAR;
        PG8_STAGE(PG8_SB(1, 0), cB + kstep, voffB); PG8_STAGE(PG8_SA(1, 0), cA + kstep, voffA); PG8_STAGE(PG8_SB(1, 1), cB + hstepB + kstep, voffB);
        PG8_WAIT_V(6); PG8_BAR;
    } else {
        PG8_STAGE(PG8_SB(0, 0), cB, voffB); PG8_STAGE(PG8_SA(0, 0), cA, voffA); PG8_STAGE(PG8_SB(0, 1), cB + hstepB, voffB); PG8_STAGE(PG8_SA(0, 1), cA + hstepA, voffA);
        if (wr == 1) PG8_BAR;
        PG8_WAIT_V(4); PG8_BAR;
        PG8_STAGE(PG8_SB(1, 0), cB + kstep, voffB); PG8_STAGE(PG8_SA(1, 0), cA + kstep, voffA); PG8_STAGE(PG8_SB(1, 1), cB + hstepB + kstep, voffB);
        PG8_WAIT_V(6); PG8_BAR;
    }
    for (;;) {
        const bool has_next = S.next(ui + 1, nxt);
        const char* nA = has_next ? (const char*)g.A + (size_t)nxt.pm * tstepA : cA; const char* nB = has_next ? (const char*)g.Bt + (size_t)nxt.pn * tstepB : cB;
        for (int t = 0; t < nt; t += 2) {
            const bool last = (t == nt - 2);
            const char* a1 = cA + (size_t)(t + 1) * kstep;
            const char* a2 = last ? nA : cA + (size_t)(t + 2) * kstep; const char* b2 = last ? nB : cB + (size_t)(t + 2) * kstep;
            const char* a3 = a2 + kstep; const char* b3 = b2 + kstep;
            if (last && has_next) S.a_ready(nxt);
            if constexpr (SP2) {
            PG8_LDB(B0, 0, 0); PG8_LDB(B1, 0, 1); PG8_SCHED; PG8_LDA(At, 0, 0); PG8_STAGE(PG8_SA(1, 1), a1 + hstepA, voffA);
            PG8_WAIT_V(8); PG8_WAIT_L(0); PG8_BAR; PG8_MMA(0, 0, At, B0); PG8_MMA(0, 1, At, B1); PG8_BAR; PG8_SCHED;
            PG8_LDA(At, 0, 1); PG8_STAGE(PG8_SB(0, 0), b2, voffB); PG8_STAGE(PG8_SB(0, 1), b2 + hstepB, voffB); PG8_STAGE(PG8_SA(0, 0), a2, voffA);
            PG8_WAIT_V(8); PG8_WAIT_L(0); PG8_BAR; PG8_MMA(1, 0, At, B0); PG8_MMA(1, 1, At, B1); PG8_BAR; PG8_SCHED;
            PG8_LDB(B0, 1, 0); PG8_LDB(B1, 1, 1); PG8_SCHED; PG8_LDA(At, 1, 0); PG8_STAGE(PG8_SA(0, 1), a2 + hstepA, voffA);
            PG8_WAIT_V(8); PG8_WAIT_L(0); PG8_BAR; PG8_MMA(0, 0, At, B0); PG8_MMA(0, 1, At, B1); PG8_BAR; PG8_SCHED;
            PG8_LDA(At, 1, 1); PG8_STAGE(PG8_SB(1, 0), b3, voffB); PG8_STAGE(PG8_SB(1, 1), b3 + hstepB, voffB); PG8_STAGE(PG8_SA(1, 0), a3, voffA);
            PG8_WAIT_V(8); PG8_WAIT_L(0); PG8_BAR; PG8_MMA(1, 0, At, B0); PG8_MMA(1, 1, At, B1); PG8_BAR; PG8_SCHED;
            } else {
            PG8_LDB(B0, 0, 0); PG8_SCHED; PG8_LDA(At, 0, 0); PG8_STAGE(PG8_SA(1, 1), a1 + hstepA, voffA);
            PG8_WAIT_L(8); PG8_BAR; PG8_WAIT_L(0); PG8_MMA(0, 0, At, B0); PG8_BAR; PG8_SCHED;
            PG8_LDB(B1, 0, 1); PG8_STAGE(PG8_SB(0, 0), b2, voffB);
            PG8_BAR; PG8_WAIT_L(0); PG8_MMA(0, 1, At, B1); PG8_BAR;
            PG8_LDA(At, 0, 1); PG8_STAGE(PG8_SA(0, 0), a2, voffA);
            PG8_BAR; PG8_WAIT_L(0); PG8_MMA(1, 0, At, B0); PG8_BAR; PG8_SCHED;
            PG8_STAGE(PG8_SB(0, 1), b2 + hstepB, voffB);
            PG8_WAIT_V(6); PG8_BAR; PG8_MMA(1, 1, At, B1); PG8_BAR;
            PG8_LDB(B0, 1, 0); PG8_SCHED; PG8_LDA(At, 1, 0); PG8_STAGE(PG8_SA(0, 1), a2 + hstepA, voffA);
            PG8_WAIT_L(8); PG8_BAR; PG8_WAIT_L(0); PG8_MMA(0, 0, At, B0); PG8_BAR; PG8_SCHED;
            PG8_LDB(B1, 1, 1); PG8_STAGE(PG8_SB(1, 0), b3, voffB);
            PG8_BAR; PG8_WAIT_L(0); PG8_MMA(0, 1, At, B1); PG8_BAR;
            PG8_LDA(At, 1, 1); PG8_STAGE(PG8_SA(1, 0), a3, voffA);
            PG8_BAR; PG8_WAIT_L(0); PG8_MMA(1, 0, At, B0); PG8_BAR; PG8_SCHED;
            PG8_STAGE(PG8_SB(1, 1), b3 + hstepB, voffB);
            PG8_WAIT_V(6); PG8_BAR; PG8_MMA(1, 1, At, B1); PG8_BAR;
            }
        }
        if constexpr (ALIGN_EPI) { if (wr == 0) PG8_BAR; }
        if constexpr (!Epi::AFTER_DRAIN) { E(acc, cur, wr, wc, fr, fq); S.done(cur); }
        if (!has_next) break;
#pragma unroll
        for (int a = 0; a < 2; ++a)
#pragma unroll
            for (int b = 0; b < 2; ++b)
#pragma unroll
                for (int m = 0; m < 4; ++m)
#pragma unroll
                    for (int n = 0; n < 2; ++n) acc[a][b][m][n] = (f32x4){0.f, 0.f, 0.f, 0.f};
        cur = nxt; cA = nA; cB = nB; ++ui;
        if constexpr (ALIGN_EPI) { if (wr == 1) PG8_BAR; }
    }
    PG8_WAIT_V(0);
    if constexpr (!ALIGN_EPI) { if (wr == 0) PG8_BAR; }
    PG8_BAR;
    if constexpr (Epi::AFTER_DRAIN) { E.fused(acc, cur, wr, wc, fr, fq, lds, wid, lane); S.done(cur); }
#undef PG8_SA
#undef PG8_SB
#undef PG8_STAGE
#undef PG8_LDA
#undef PG8_LDB
#undef PG8_MMA
#undef PG8_WAIT_V
#undef PG8_WAIT_L
#undef PG8_BAR
#undef PG8_SCHED
}
}

#ifndef PG8_SP2
#define PG8_SP2 true
#endif
#ifndef PG8_ALIGN
#define PG8_ALIGN true
#endif
namespace pg8 {
struct EpiResF32 {
    static constexpr bool PERM = false, AFTER_DRAIN = false;
    const float* base; float* out; int ldc; float alpha;
    __device__ __forceinline__ void operator()(const f32x4 (&acc)[2][2][4][2], const Unit& u, int wr, int wc, int fr, int fq) const {
        const int col0 = u.pn * BM + wc * 32 + 4 * fq;
#pragma unroll
        for (int ai = 0; ai < 2; ++ai)
#pragma unroll
            for (int m = 0; m < 4; ++m) { const size_t off = (size_t)(u.pm * BM + ai * HALF + wr * 64 + m * 16 + fr) * ldc + col0;
#pragma unroll
                for (int bj = 0; bj < 2; ++bj)
#pragma unroll
                    for (int n = 0; n < 2; ++n) { const f32x4 bs = *(const f32x4*)(base + off + bj * HALF + n * 16); *(f32x4*)(out + off + bj * HALF + n * 16) = bs * alpha + acc[ai][bj][m][n]; }
                asm volatile("" ::: "memory"); }
    }
};
struct EpiL1In {
    static constexpr bool PERM = true, AFTER_DRAIN = false;
    bf16_t *Qd, *KL, *QI, *KI; float* WI; const float* csq; const float* csi; float wscale;
    __device__ __forceinline__ void operator()(const f32x4 (&acc)[2][2][4][2], const Unit& u, int wr, int wc, int fr, int fq) const {
        const int pn = u.pn, row0 = u.pm * BM + wr * 64 + fr;
#pragma unroll
        for (int bj = 0; bj < 2; ++bj) {
            const int c0 = bj * HALF + wc * 32 + 8 * fq;
            int kind = 0, pb = 0, ld = 0, dcol = 0; bf16_t* dst = nullptr; bool f32out = false, skip = false;
            if (pn < 16) { dst = Qd; ld = 4096; dcol = pn * 256 + c0; kind = c0 < 64 ? 1 : 0; pb = c0 >> 1; }
            else if (pn == 16) { dst = KL; ld = 256; dcol = c0; kind = c0 < 64 ? 1 : 0; pb = c0 >> 1; }
            else if (pn < 21) { dst = QI; ld = 1024; dcol = (pn - 17) * 256 + c0; const int j0 = c0 & 63; kind = j0 < 16 ? 2 : 0; pb = j0 >> 1; }
            else { if (c0 < 64) { dst = KI; ld = 64; dcol = c0; kind = c0 < 16 ? 2 : 0; pb = c0 >> 1; } else if (c0 < 80) { f32out = true; dcol = c0 - 64; } else skip = true; }
            if (skip) continue;
#pragma unroll
            for (int ai = 0; ai < 2; ++ai)
#pragma unroll
                for (int m = 0; m < 4; ++m) { const int row = row0 + ai * HALF + m * 16;
                    f32x4 v0 = acc[ai][bj][m][0], v1 = acc[ai][bj][m][1];
                    if (kind) { const float* cs = (kind == 1 ? csq + (size_t)row * 64 : csi + (size_t)row * 16) + pb * 2;
                        const f32x4 c01 = *(const f32x4*)cs, c23 = *(const f32x4*)(cs + 4);
                        f32x4 r0, r1;
                        r0[0] = v0[0] * c01[0] - v0[1] * c01[1]; r0[1] = v0[1] * c01[0] + v0[0] * c01[1];
                        r0[2] = v0[2] * c01[2] - v0[3] * c01[3]; r0[3] = v0[3] * c01[2] + v0[2] * c01[3];
                        r1[0] = v1[0] * c23[0] - v1[1] * c23[1]; r1[1] = v1[1] * c23[0] + v1[0] * c23[1];
                        r1[2] = v1[2] * c23[2] - v1[3] * c23[3]; r1[3] = v1[3] * c23[2] + v1[2] * c23[3];
                        v0 = r0; v1 = r1; }
                    if (f32out) { float* o = WI + (size_t)row * 16 + dcol; *(f32x4*)o = v0 * wscale; *(f32x4*)(o + 4) = v1 * wscale; }
                    else { u32x4 w; w.x = cvt_pk_bf16(v0[0], v0[1]); w.y = cvt_pk_bf16(v0[2], v0[3]); w.z = cvt_pk_bf16(v1[0], v1[1]); w.w = cvt_pk_bf16(v1[2], v1[3]);
                        *(u32x4*)(dst + (size_t)row * ld + dcol) = w; }
                    asm volatile("" ::: "memory"); }
        }
    }
};
}
constexpr int NWAVES = 8;
constexpr int BATCH = 2, SEQ = 8192, DM = 1024, M = BATCH * SEQ;
constexpr int FF = 2816, FF2 = 2 * FF, NQKV0 = 3072, N1PAD = 5632, W_IN_AB = 3080, W_IN_C = 5456;
constexpr float LN_EPS = 1e-5f, ALPHA = 1.4142135623730951f;
constexpr float IDX_SCALE = 0.03125f, DSA_SCALE = 0.0625f;
constexpr int NIN = 24;
constexpr size_t MiB = 1u << 20;
constexpr size_t WS_CTL = 0, CTL_ZERO_BYTES = 64 * 1024;
constexpr size_t WS_LSF = 1 * MiB, WS_CUM = WS_LSF + 512 * 1024;
constexpr size_t WS_XB = 2 * MiB;
constexpr size_t WS_W0IN = 34 * MiB, WS_W0O = 40 * MiB, WS_W0UP = 42 * MiB, WS_W0DN = 53 * MiB;
constexpr size_t WS_W1IN = 34 * MiB, WS_WC = 45 * MiB, WS_CSQ = 51 * MiB, WS_CSI = 55 * MiB, WS_WI = 56 * MiB, WS_KI = 57 * MiB;
constexpr size_t WS_BIG = 59 * MiB;
constexpr size_t WS_QO = WS_BIG, WS_K = WS_QO + 32 * MiB, WS_V = WS_K + 32 * MiB;
constexpr size_t WS_H = WS_BIG;
constexpr size_t WS_QD = WS_BIG, WS_QI = WS_QD + 128 * MiB, WS_KL = WS_QI + 32 * MiB, WS_IDX = WS_KL + 8 * MiB;
constexpr size_t WS_W1UP = 235 * MiB, WS_W1DN = 246 * MiB, WS_END = 256 * MiB;
static_assert(WS_H + (size_t)M * FF2 * 2 <= WS_W1UP && WS_IDX + (size_t)M * 256 * 2 <= WS_W1UP && WS_W1DN + (size_t)DM * FF * 2 <= WS_END && WS_W0DN + (size_t)DM * FF * 2 <= WS_BIG && WS_KI + (size_t)M * 64 * 2 <= WS_BIG, "d_ws map");
constexpr int CW_TMO = 0, CW_CODE = 1, CW_KN = 64, CW_BAR = 4096;
constexpr int RING_OFF = 0, RING_BYTES = 145408;
constexpr int LDSCTL_OFF = RING_BYTES, MISC_OFF = LDSCTL_OFF + 320;
constexpr int LDS_BYTES = 147456;
#define GAS __attribute__((address_space(1)))
#define LAS __attribute__((address_space(3)))
typedef unsigned short bf16;
typedef unsigned v4u __attribute__((ext_vector_type(4)));
typedef float f32x4 __attribute__((ext_vector_type(4)));
typedef short bf16x8 __attribute__((ext_vector_type(8)));
typedef GAS unsigned gu32;
typedef GAS unsigned long long gu64;
#define RLX_AGENT __ATOMIC_RELAXED, __HIP_MEMORY_SCOPE_AGENT
#define LDS_WAIT() asm volatile("s_waitcnt lgkmcnt(0)" ::: "memory")
#define VM_WAIT() asm volatile("s_waitcnt vmcnt(0)" ::: "memory")
__device__ __forceinline__ unsigned long long rt() { return __builtin_amdgcn_s_memrealtime(); }
__device__ __forceinline__ unsigned f2bf(float f) { unsigned u = __builtin_bit_cast(unsigned, f); return (u + 0x7fffu + ((u >> 16) & 1u)) >> 16; }
__device__ __forceinline__ unsigned pk2(float lo, float hi) { return f2bf(lo) | (f2bf(hi) << 16); }

#define XB_TMO      128
#define XB_XCNT(j)  (256  + 64 * (j))
#define XB_XSUB(j)  (1280 + 64 * (j))
#define XB_XGEN(j)  (2304 + 64 * (j))
#define XB_TOP      3328
#define XB_TOPGEN   3392
#define XCD_BAR_WORDS 3456
#define XB_SPIN_CAP (1u << 18)

__device__ __forceinline__ unsigned xb_ld(unsigned* p)              { return __hip_atomic_load(p, __ATOMIC_RELAXED, __HIP_MEMORY_SCOPE_AGENT); }
__device__ __forceinline__ unsigned xb_add(unsigned* p, unsigned v) { return __hip_atomic_fetch_add(p, v, __ATOMIC_RELAXED, __HIP_MEMORY_SCOPE_AGENT); }
__device__ __forceinline__ unsigned xb_xcc_id() { return (unsigned)__builtin_amdgcn_s_getreg((3 << 11) | 20) & 0xFu; }
#define XB_SPIN(cond, bar) do { unsigned _sp = 0; while (cond) { __builtin_amdgcn_s_sleep(1); \
    if ((++_sp & 255u) == 0u) { if (xb_ld(&(bar)[XB_TMO])) break; if (_sp > XB_SPIN_CAP) { atomicAdd(&(bar)[XB_TMO], 1u); break; } } } } while (0)

struct XcdBarrier {
    unsigned* bar; unsigned x;
    volatile LAS unsigned* st;
};

__device__ __forceinline__ XcdBarrier xcd_barrier_post(unsigned* bar, volatile LAS unsigned* st) {
    XcdBarrier b; b.bar = bar; b.x = xb_xcc_id(); b.st = st;
    if (threadIdx.x == 0) (void)xb_add(&bar[XB_XCNT(b.x)], 1u);
    return b;
}
__device__ __forceinline__ void xcd_barrier_complete(unsigned* bar, unsigned x, unsigned& nloc, unsigned& nx) {
    const unsigned G = gridDim.x * gridDim.y * gridDim.z;
    unsigned sum, cnt, mine, sp = 0u;
    for (;;) {
        sum = 0u; cnt = 0u; mine = 0u;
#pragma unroll
        for (unsigned j = 0; j < 16; ++j) { const unsigned c = xb_ld(&bar[XB_XCNT(j)]); sum += c; cnt += (c > 0u) ? 1u : 0u; mine = (j == x) ? c : mine; }
        if (sum == G) break;
        __builtin_amdgcn_s_sleep(1);
        if ((++sp & 255u) == 0u) { if (xb_ld(&bar[XB_TMO])) break; if (sp > XB_SPIN_CAP) { atomicAdd(&bar[XB_TMO], 1u); break; } }
    }
    nloc = mine > 0u ? mine : 1u; nx = cnt > 0u ? cnt : 1u;
}

__device__ __forceinline__ void xcd_barrier(const XcdBarrier& b) {
    asm volatile("s_waitcnt vmcnt(0)" ::: "memory");
    __syncthreads();
    if (threadIdx.x == 0) {
        unsigned* bar = b.bar;
        __builtin_amdgcn_s_waitcnt(0);
        unsigned nloc = b.st[0], nx = b.st[1];
        if (nloc == 0u) { xcd_barrier_complete(bar, b.x, nloc, nx); b.st[0] = nloc; b.st[1] = nx; }
        const unsigned old = xb_add(&bar[XB_XSUB(b.x)], 1u);
        const unsigned gen = old / nloc;
        if (old + 1u == (gen + 1u) * nloc) {
            __builtin_amdgcn_fence(__ATOMIC_RELEASE, "agent");
            asm volatile("s_waitcnt vmcnt(0)" ::: "memory");
            const unsigned og = xb_add(&bar[XB_TOP], 1u);
            const unsigned tg = og / nx;
            if (og + 1u == (tg + 1u) * nx) xb_add(&bar[XB_TOPGEN], 1u);
            else XB_SPIN(xb_ld(&bar[XB_TOPGEN]) == tg, bar);
            __builtin_amdgcn_fence(__ATOMIC_ACQUIRE, "agent");
            xb_add(&bar[XB_XGEN(b.x)], 1u);
            asm volatile("s_waitcnt vmcnt(0)" ::: "memory");
        } else {
            XB_SPIN(xb_ld(&bar[XB_XGEN(b.x)]) == gen, bar);
            __builtin_amdgcn_fence(__ATOMIC_ACQUIRE, "agent");
            asm volatile("s_waitcnt vmcnt(0)" ::: "memory");
        }
    }
    __syncthreads();
}

typedef float f32x16 __attribute__((ext_vector_type(16)));
typedef unsigned v2u __attribute__((ext_vector_type(2)));
typedef short s16x4 __attribute__((ext_vector_type(4)));
typedef unsigned short u16;
struct Args { const float* in[NIN]; float* out; unsigned char* ws; };
struct Frame {
    LAS unsigned char* lds; volatile LAS unsigned* MISC; gu32* ctl;
    int tid, lane, wave, G, vcu;
    unsigned char* ws; float* out;
};
__device__ __forceinline__ float wave_sum(float v) {
#pragma unroll
    for (int o = 1; o < 64; o <<= 1) v += __shfl_xor(v, o);
    return v;
}
__device__ __forceinline__ const float* argp(int k) { const __attribute__((address_space(4))) char* p = (const __attribute__((address_space(4))) char*)__builtin_amdgcn_kernarg_segment_ptr(); asm volatile("" : "+s"(p)); return *(const float* const __attribute__((address_space(4)))*)(p + 8 * k); }
__device__ __forceinline__ int opaque(int v) { asm volatile("" : "+v"(v)); return v; }
__device__ __forceinline__ float bf2f(unsigned short b) { return __uint_as_float((unsigned)b << 16); }
__device__ __forceinline__ float bflo(unsigned w) { return __uint_as_float(w << 16); }
__device__ __forceinline__ float bfhi(unsigned w) { return __uint_as_float(w & 0xffff0000u); }
__device__ __forceinline__ unsigned cvtpk(float lo, float hi) { unsigned r; asm volatile("v_cvt_pk_bf16_f32 %0, %1, %2" : "=v"(r) : "v"(lo), "v"(hi)); return r; }

constexpr int TR_ROWB = 144;
template <int ROT> __device__ __forceinline__ int tr_dst(int j) { if (ROT == 0 || j >= ROT) return j; return 2 * (j & (ROT / 2 - 1)) + (j / (ROT / 2)); }
struct TrItem { const float* W; int Nsrc, K, sbase, nvalid, k0; bf16* WT; int n0; };
__device__ __forceinline__ void tr_load(const TrItem& it, f32x4 (&v)[16], int lane) {
    const int nl = lane & 15, kq = lane >> 4; const bool ok = 4 * nl < it.nvalid;
    const float* src = it.W + (size_t)(it.k0 + 16 * kq) * it.Nsrc + it.sbase + 4 * nl;
#pragma unroll
    for (int i = 0; i < 16; ++i) v[i] = ok ? *(const GAS f32x4*)(src + (size_t)i * it.Nsrc) : (f32x4){0.f, 0.f, 0.f, 0.f};
}
template <int ROT> __device__ __forceinline__ void tr_store(const TrItem& it, const f32x4 (&v)[16], LAS unsigned char* scr, int lane) {
    const int nl = lane & 15, kq = lane >> 4;
#pragma unroll
    for (int e = 0; e < 4; ++e) { const int n = tr_dst<ROT>(4 * nl + e);
        v4u w0, w1;
        w0.x = pk2(v[0][e], v[1][e]); w0.y = pk2(v[2][e], v[3][e]); w0.z = pk2(v[4][e], v[5][e]); w0.w = pk2(v[6][e], v[7][e]);
        w1.x = pk2(v[8][e], v[9][e]); w1.y = pk2(v[10][e], v[11][e]); w1.z = pk2(v[12][e], v[13][e]); w1.w = pk2(v[14][e], v[15][e]);
        *(LAS v4u*)(scr + n * TR_ROWB + kq * 32) = w0; *(LAS v4u*)(scr + n * TR_ROWB + kq * 32 + 16) = w1; }
    LDS_WAIT(); asm volatile("" ::: "memory");
    const int c = lane & 7, r8 = lane >> 3;
#pragma unroll
    for (int j = 0; j < 8; ++j) { const int n = 8 * j + r8; const v4u o = *(const LAS v4u*)(scr + n * TR_ROWB + c * 16);
        *(GAS v4u*)(it.WT + (size_t)(it.n0 + n) * it.K + it.k0 + 8 * c) = o; }
    LDS_WAIT(); asm volatile("" ::: "memory");
}
__device__ __forceinline__ TrItem tr_plain(const float* W, int K, int N, bf16* WT, int item) { const int nt = N / 64, kb = item / nt, t = item % nt; return TrItem{W, N, K, 64 * t, 64, 64 * kb, WT, 64 * t}; }
__device__ __forceinline__ TrItem tr_l0in(const float* W, bf16* WT, int item) { const int nt = NQKV0 / 64, kb = item / nt, t = item % nt, blk = t >> 3, sb = (blk & 1) * 3 + (blk >> 1);
    return TrItem{W, W_IN_AB, DM, sb * 512 + (t & 7) * 64, 64, 64 * kb, WT, 64 * t}; }
__device__ __forceinline__ TrItem tr_l1in(const float* W, bf16* WT, int item, int& rot) { const int nt = N1PAD / 64, kb = item / nt, t = item % nt;
    int nvalid = 64; rot = 0;
    if (t < 68) rot = (t & 3) == 0 ? 64 : 0; else if (t < 85) rot = 16; else if (t == 85) nvalid = 16; else nvalid = 0;
    return TrItem{W, W_IN_C, DM, 64 * t, nvalid, 64 * kb, WT, 64 * t}; }
__device__ __forceinline__ void p0_row(const f32x4 (&v)[4], bf16* orow, float* lsf, const LAS float* wf, const float* bfv, int lane) {
    GAS unsigned long long* o8 = (GAS unsigned long long*)orow + lane;
#pragma unroll
    for (int j = 0; j < 4; ++j) o8[64 * j] = (unsigned long long)pk2(v[j].x, v[j].y) | ((unsigned long long)pk2(v[j].z, v[j].w) << 32);
    float a[8] = {0.f, 0.f, 0.f, 0.f, 0.f, 0.f, 0.f, 0.f};
#pragma unroll
    for (int j = 0; j < 4; ++j)
#pragma unroll
        for (int e = 0; e < 4; ++e) { const int k = 256 * j + 4 * lane + e; const f32x4 w0 = *(const LAS f32x4*)(wf + k * 8), w1 = *(const LAS f32x4*)(wf + k * 8 + 4); const float xv = v[j][e];
            a[0] += xv * w0[0]; a[1] += xv * w0[1]; a[2] += xv * w0[2]; a[3] += xv * w0[3]; a[4] += xv * w1[0]; a[5] += xv * w1[1]; a[6] += xv * w1[2]; a[7] += xv * w1[3]; }
    const bool b0 = lane & 1, b1 = lane & 2, b2 = lane & 4;
    float c[4], d[2];
#pragma unroll
    for (int i = 0; i < 4; ++i) { const float snd = b0 ? a[i] : a[4 + i], keep = b0 ? a[4 + i] : a[i]; c[i] = keep + __shfl_xor(snd, 1); }
#pragma unroll
    for (int i = 0; i < 2; ++i) { const float snd = b1 ? c[i] : c[2 + i], keep = b1 ? c[2 + i] : c[i]; d[i] = keep + __shfl_xor(snd, 2); }
    float e1; { const float snd = b2 ? d[0] : d[1], keep = b2 ? d[1] : d[0]; e1 = keep + __shfl_xor(snd, 4); }
    e1 += __shfl_xor(e1, 8); e1 += __shfl_xor(e1, 16); e1 += __shfl_xor(e1, 32);
    if (lane < 8) { const int h = 4 * (lane & 1) + 2 * ((lane >> 1) & 1) + ((lane >> 2) & 1); const float f = e1 + bfv[h]; lsf[h] = -(fmaxf(-f, 0.f) + log1pf(__expf(-fabsf(f)))); }
}
__device__ __forceinline__ void p0_prologue(Frame& F) {
    const int tid_ = opaque(F.tid), lane_ = tid_ & 63;
    LAS float* wf = (LAS float*)(F.lds + RING_OFF + 73728);
    const float* w0in = argp(2);
    for (int i = tid_; i < 1024 * 8; i += NWAVES * 64) wf[i] = w0in[(size_t)(i >> 3) * W_IN_AB + 3072 + (i & 7)];
    __syncthreads();
    const int gw = F.vcu * NWAVES + F.wave, NGW = F.G * NWAVES;
    constexpr int I_IN = 16 * (NQKV0 / 64), I_O = 16 * 16, I_UP = 16 * (FF2 / 64), I_DN = (FF / 64) * 16;
    constexpr int NITEMS = I_IN + I_O + 2 * I_UP + 2 * I_DN;
    LAS unsigned char* scrb = F.lds + RING_OFF + F.wave * 9216;
    for (int it = gw; it < NITEMS; it += NGW) {
        int r = it; TrItem ti;
        if (r < I_IN) ti = tr_l0in(argp(2), (bf16*)(F.ws + WS_W0IN), r);
        else if ((r -= I_IN) < I_O) ti = tr_plain(argp(4), DM, DM, (bf16*)(F.ws + WS_W0O), r);
        else if ((r -= I_O) < I_UP) ti = tr_plain(argp(7), DM, FF2, (bf16*)(F.ws + WS_W0UP), r);
        else if ((r -= I_UP) < I_DN) ti = tr_plain(argp(10), FF, DM, (bf16*)(F.ws + WS_W0DN), r);
        else if ((r -= I_DN) < I_UP) ti = tr_plain(argp(18), DM, FF2, (bf16*)(F.ws + WS_W1UP), r);
        else { r -= I_UP; ti = tr_plain(argp(21), FF, DM, (bf16*)(F.ws + WS_W1DN), r); }
        f32x4 v[16]; tr_load(ti, v, lane_); tr_store<0>(ti, v, scrb, lane_);
    }
    const float* x = argp(0); bf16* XB = (bf16*)(F.ws + WS_XB); float* LSF = (float*)(F.ws + WS_LSF);
    const float* bfv = argp(3);
    f32x4 vn[4];
    if (gw < M) {
#pragma unroll
        for (int j = 0; j < 4; ++j) vn[j] = ((const GAS f32x4*)(x + (size_t)gw * DM) + lane_)[64 * j]; }
    for (int m = gw; m < M; m += NGW) {
        f32x4 vc[4];
#pragma unroll
        for (int j = 0; j < 4; ++j) vc[j] = vn[j];
        if (m + NGW < M) {
#pragma unroll
            for (int j = 0; j < 4; ++j) vn[j] = ((const GAS f32x4*)(x + (size_t)(m + NGW) * DM) + lane_)[64 * j]; }
        p0_row(vc, XB + (size_t)m * DM, LSF + (size_t)m * 8, wf, bfv, lane_);
    }
}

__device__ __forceinline__ void p1b_scan_kn(Frame& F) {
    const int tid_ = opaque(F.tid), lane_ = tid_ & 63;
    const float* LSF = (const float*)(F.ws + WS_LSF); float* CUM = (float*)(F.ws + WS_CUM);
    if (blockIdx.x < 16) {
        const int b = blockIdx.x >> 3, h = blockIdx.x & 7, t0 = 16 * tid_;
        float v[16]; float s = 0.f;
#pragma unroll
        for (int j = 0; j < 16; ++j) { s += LSF[(size_t)(b * SEQ + t0 + j) * 8 + h]; v[j] = s; }
        float inc = s;
#pragma unroll
        for (int o = 1; o < 64; o <<= 1) { const float u = __shfl_up(inc, o); if (lane_ >= o) inc += u; }
        LAS float* wt = (LAS float*)(F.lds + RING_OFF);
        if (lane_ == 63) wt[F.wave] = inc;
        __syncthreads();
        float off = inc - s;
        for (int w = 0; w < F.wave; ++w) off += wt[w];
#pragma unroll
        for (int j = 0; j < 16; ++j) CUM[(size_t)(b * 8 + h) * SEQ + t0 + j] = off + v[j];
        __syncthreads();
    } else {
        const bf16* KB = (const bf16*)(F.ws + WS_K);
        const int gw = (blockIdx.x - 16) * NWAVES + F.wave, NGW = (F.G - 16) * NWAVES;
        float mx0 = 0.f, mx1 = 0.f;
        for (int m = gw; m < M; m += NGW) {
            const v4u w = *(const GAS v4u*)(KB + (size_t)m * DM + 512 + lane_ * 8);
            float s = bflo(w.x) * bflo(w.x) + bfhi(w.x) * bfhi(w.x) + bflo(w.y) * bflo(w.y) + bfhi(w.y) * bfhi(w.y) + bflo(w.z) * bflo(w.z) + bfhi(w.z) * bfhi(w.z) + bflo(w.w) * bflo(w.w) + bfhi(w.w) * bfhi(w.w);
            s += __shfl_xor(s, 1); s += __shfl_xor(s, 2); s += __shfl_xor(s, 4);
            if (m < SEQ) mx0 = fmaxf(mx0, s); else mx1 = fmaxf(mx1, s);
        }
        if ((lane_ & 7) == 0) { atomicMax((unsigned*)(F.ctl + CW_KN) + (lane_ >> 3), __float_as_uint(mx0)); atomicMax((unsigned*)(F.ctl + CW_KN) + 8 + (lane_ >> 3), __float_as_uint(mx1)); }
    }
}
__device__ __forceinline__ void ln_phase(Frame& F, float* y, const float* g, const float* bta, bf16* xb) {
    const int tid_ = opaque(F.tid), lane_ = tid_ & 63;
    const int gw = F.vcu * NWAVES + F.wave, NGW = F.G * NWAVES;
    f32x4 gv[4], bv[4];
#pragma unroll
    for (int j = 0; j < 4; ++j) { gv[j] = ((const GAS f32x4*)g)[lane_ + 64 * j]; bv[j] = ((const GAS f32x4*)bta)[lane_ + 64 * j]; }
    for (int m = gw; m < M; m += NGW) {
        GAS f32x4* yr = (GAS f32x4*)(y + (size_t)m * DM) + lane_;
        f32x4 v[4]; float s = 0.f;
#pragma unroll
        for (int j = 0; j < 4; ++j) { v[j] = yr[64 * j]; s += (v[j].x + v[j].y) + (v[j].z + v[j].w); }
        const float mean = wave_sum(s) * (1.f / DM); float s2 = 0.f;
#pragma unroll
        for (int j = 0; j < 4; ++j) { v[j] = v[j] - mean; s2 += (v[j].x * v[j].x + v[j].y * v[j].y) + (v[j].z * v[j].z + v[j].w * v[j].w); }
        const float rstd = 1.f / sqrtf(wave_sum(s2) * (1.f / DM) + LN_EPS);
#pragma unroll
        for (int j = 0; j < 4; ++j) { v[j] = v[j] * rstd * gv[j] + bv[j]; yr[64 * j] = v[j]; }
        if (xb) { GAS unsigned long long* o8 = (GAS unsigned long long*)(xb + (size_t)m * DM) + lane_;
#pragma unroll
            for (int j = 0; j < 4; ++j) o8[64 * j] = (unsigned long long)pk2(v[j].x, v[j].y) | ((unsigned long long)pk2(v[j].z, v[j].w) << 32); }
    }
}
__device__ __forceinline__ float gelu_tanh(float x) { const float u = 0.7978845608028654f * (x + 0.044715f * x * x * x); return x / (1.f + __expf(-2.f * u)); }
__device__ __forceinline__ void conv_phase(Frame& F, bf16* H, const float* cw, const float* cb) {
    const int tid_ = opaque(F.tid), lane_ = tid_ & 63; (void)lane_;
    constexpr int NCG = FF / 8, NRUN = M / 16;
    const int gt = F.vcu * (NWAVES * 64) + tid_, NGT = F.G * NWAVES * 64;
    for (int it = gt; it < NCG * NRUN; it += NGT) {
        const int cg = it % NCG, run = it / NCG, c0 = cg * 8, row0 = run * 16;
        float w0[8], w1[8], w2[8], b0[8];
#pragma unroll
        for (int e = 0; e < 8; ++e) { w0[e] = cw[c0 + e]; w1[e] = cw[FF + c0 + e]; w2[e] = cw[2 * FF + c0 + e]; b0[e] = cb[c0 + e]; }
        v4u g2 = (v4u){0u, 0u, 0u, 0u}, g1 = g2;
        if ((row0 & (SEQ - 1)) != 0) { g2 = *(const GAS v4u*)(H + (size_t)(row0 - 2) * FF2 + c0); g1 = *(const GAS v4u*)(H + (size_t)(row0 - 1) * FF2 + c0); }
#pragma unroll 1
        for (int jb = 0; jb < 16; jb += 4) {
            v4u gq[4], uq[4];
#pragma unroll
            for (int j = 0; j < 4; ++j) { const size_t off = (size_t)(row0 + jb + j) * FF2 + c0; gq[j] = *(const GAS v4u*)(H + off); uq[j] = *(const GAS v4u*)(H + off + FF); }
#pragma unroll
            for (int j = 0; j < 4; ++j) {
                const size_t off = (size_t)(row0 + jb + j) * FF2 + c0;
                const v4u g0 = gq[j], uu = uq[j];
                unsigned gg2[4] = {g2.x, g2.y, g2.z, g2.w}, gg1[4] = {g1.x, g1.y, g1.z, g1.w}, gg0[4] = {g0.x, g0.y, g0.z, g0.w}, u4[4] = {uu.x, uu.y, uu.z, uu.w}, o[4];
#pragma unroll
                for (int p = 0; p < 4; ++p) {
                    const float ca = b0[2 * p] + w0[2 * p] * bflo(gg2[p]) + w1[2 * p] * bflo(gg1[p]) + w2[2 * p] * bflo(gg0[p]);
                    const float cb2 = b0[2 * p + 1] + w0[2 * p + 1] * bfhi(gg2[p]) + w1[2 * p + 1] * bfhi(gg1[p]) + w2[2 * p + 1] * bfhi(gg0[p]);
                    o[p] = pk2(gelu_tanh(ca) * bflo(u4[p]), gelu_tanh(cb2) * bfhi(u4[p]));
                }
                *(GAS v4u*)(H + off + FF) = (v4u){o[0], o[1], o[2], o[3]};
                g2 = g1; g1 = g0;
            }
        }
    }
}
__device__ __forceinline__ void p8_prep(Frame& F) {
    const int tid_ = opaque(F.tid), lane_ = tid_ & 63;
    LAS unsigned char* scrb = F.lds + RING_OFF + F.wave * 9216;
    const int gw = F.vcu * NWAVES + F.wave, NGW = F.G * NWAVES;
    constexpr int I_IN1 = 16 * (N1PAD / 64);
    for (int it = gw; it < I_IN1; it += NGW) { int rot; const TrItem ti = tr_l1in(argp(13), (bf16*)(F.ws + WS_W1IN), it, rot);
        f32x4 v[16]; tr_load(ti, v, lane_);
        if (rot == 64) tr_store<64>(ti, v, scrb, lane_); else if (rot == 16) tr_store<16>(ti, v, scrb, lane_); else tr_store<0>(ti, v, scrb, lane_); }
    const int gt = F.vcu * (NWAVES * 64) + tid_, NGT = F.G * NWAVES * 64;
    const float* wuv = argp(14); const float* wo = argp(15); bf16* WcT = (bf16*)(F.ws + WS_WC);
    for (int it = gt; it < 1024 * 384; it += NGT) {
        const int n = it & 1023, hcg = it >> 10, h = hcg / 24, c0 = (hcg % 24) * 8;
        float a[8] = {0.f, 0.f, 0.f, 0.f, 0.f, 0.f, 0.f, 0.f};
        for (int d = 0; d < 64; ++d) { const float w = wo[(size_t)(h * 64 + d) * DM + n];
#pragma unroll
            for (int e = 0; e < 8; ++e) a[e] += wuv[(size_t)(h * 192 + c0 + e) * 64 + d] * w; }
        *(GAS v4u*)(WcT + (size_t)n * 3072 + h * 192 + c0) = (v4u){pk2(a[0], a[1]), pk2(a[2], a[3]), pk2(a[4], a[5]), pk2(a[6], a[7])};
    }
    const int* pos = (const int*)argp(1); float* csq = (float*)(F.ws + WS_CSQ); float* csi = (float*)(F.ws + WS_CSI);
    for (int it = gt; it < M * 40; it += NGT) {
        const int row = it / 40, i = it % 40;
        double fq = 1.0; { const double rr = i < 32 ? 0.6636012376960885 : 0.19392274474868576; const int ii = i < 32 ? i : i - 32; for (int q = 0; q < ii; ++q) fq *= rr; }
        const float ang = (float)pos[row] * (float)fq;
        double rev = (double)ang * 0.15915494309189535; rev -= __builtin_rint(rev);
        const float fr = (float)rev, c = __builtin_amdgcn_cosf(fr), s = __builtin_amdgcn_sinf(fr);
        float* dst = i < 32 ? csq + (size_t)row * 64 + 2 * i : csi + (size_t)row * 16 + 2 * (i - 32);
        dst[0] = c; dst[1] = s;
    }
}
constexpr int A0_K = 0, A0_V = 16384, A0_CK = 32768, A0_FLAG = 33280, A0_WS = 33344;
__device__ __forceinline__ int crow(int r, int hi) { return (r & 3) + 8 * (r >> 2) + 4 * hi; }
__device__ __forceinline__ s16x4 vtr(const LAS unsigned char* p) { return __builtin_bit_cast(s16x4, __builtin_amdgcn_ds_read_tr16_b64_v4i16((LAS s16x4*)p)); }
__device__ __forceinline__ void sb_sub(f32x16& p, int kbase, int tq, int hi, bool needmask, float& R) {
    float ls[16];
#pragma unroll
    for (int r = 0; r < 16; ++r) { const float z = p[r], e = __expf(-fabsf(z)), sp = fmaxf(z, 0.f) + __logf(1.f + e); const bool vis = !needmask || (kbase + crow(r, hi) < tq);
        ls[r] = vis ? -sp : 0.f; p[r] = vis ? (z - sp) : -INFINITY; }
    float T[4], Tp[4];
#pragma unroll
    for (int g = 0; g < 4; ++g) { T[g] = (ls[4 * g] + ls[4 * g + 1]) + (ls[4 * g + 2] + ls[4 * g + 3]); Tp[g] = __shfl_xor(T[g], 32); }
    float E = 0.f;
#pragma unroll
    for (int g = 3; g >= 0; --g) {
        const float a3 = R + E + (hi == 0 ? Tp[g] : 0.f), a2 = a3 + ls[4 * g + 3], a1 = a2 + ls[4 * g + 2], a0 = a1 + ls[4 * g + 1];
        p[4 * g + 3] = __expf(p[4 * g + 3] + a3); p[4 * g + 2] = __expf(p[4 * g + 2] + a2); p[4 * g + 1] = __expf(p[4 * g + 1] + a1); p[4 * g] = __expf(p[4 * g] + a0);
        E += T[g] + Tp[g];
    }
    R += E;
}
template <bool FOX> __device__ __forceinline__ void attn0_unit(Frame& F, int b, int h, int qb) {
    LAS unsigned char* L = F.lds + RING_OFF;
    const int tid = opaque(F.tid), lane = tid & 63, wave = F.wave, r32 = lane & 31, hi = lane >> 5;
    const bf16* Qg = (const bf16*)(F.ws + WS_QO); const bf16* Kg = (const bf16*)(F.ws + WS_K); const bf16* Vg = (const bf16*)(F.ws + WS_V); bf16* Og = (bf16*)(F.ws + WS_XB);
    const float* CUM = (const float*)(F.ws + WS_CUM) + (size_t)(b * 8 + (h & 7)) * SEQ;
    const size_t rowbase = (size_t)b * SEQ; const int q0 = qb * 256, qmin = q0 + wave * 32, qmax = qmin + 31, tq = qmin + r32;
    bf16x8 qf[4];
#pragma unroll
    for (int ks = 0; ks < 4; ++ks) qf[ks] = *(const GAS bf16x8*)(Qg + (rowbase + tq) * DM + h * 64 + 16 * ks + 8 * hi);
    float cq = 0.f, qn = 0.f, knmax = 0.f;
    if (FOX) { cq = CUM[tq]; float s = 0.f;
#pragma unroll
        for (int ks = 0; ks < 4; ++ks)
#pragma unroll
            for (int j = 0; j < 8; ++j) { const float v = bf2f((unsigned short)qf[ks][j]); s += v * v; }
        s += __shfl_xor(s, 32); qn = sqrtf(s); knmax = sqrtf(__uint_as_float(__hip_atomic_load(F.ctl + CW_KN + b * 8 + (h & 7), RLX_AGENT))); }
    f32x16 o0, o1;
#pragma unroll
    for (int r = 0; r < 16; ++r) { o0[r] = 0.f; o1[r] = 0.f; }
    float mrun = -INFINITY, lrun = 0.f, R = 0.f; bool wdone = false;
    const int kt_hi = qb * 4 + 3;
    const int skey = tid >> 3, sch = tid & 7;
    const size_t goff = (rowbase + skey) * DM + h * 64 + sch * 8;
    const int kdst = A0_K + skey * 128 + ((sch ^ (skey & 7)) * 16);
    const int vdst = A0_V + skey * 128 + (((sch >> 2) ^ ((skey >> 1) & 1)) * 64) + (sch & 3) * 16;
    LAS float* wsf = (LAS float*)(L + A0_WS) + wave * 32;
    {   const v4u kreg = *(const GAS v4u*)(Kg + goff + (size_t)kt_hi * 64 * DM), vreg = *(const GAS v4u*)(Vg + goff + (size_t)kt_hi * 64 * DM);
        *(LAS v4u*)(L + kdst) = kreg; *(LAS v4u*)(L + vdst) = vreg;
        if (FOX && tid < 64) ((LAS float*)(L + A0_CK))[tid] = CUM[kt_hi * 64 + tid]; }
    __syncthreads();
    int buf = 0;
    for (int kt = kt_hi; ; --kt) {
        const bool more = kt > 0; const int k0 = kt * 64;
        v4u kreg = (v4u){0u, 0u, 0u, 0u}, vreg = kreg; float ckreg = 0.f;
        if (more) { kreg = *(const GAS v4u*)(Kg + goff + (size_t)(kt - 1) * 64 * DM); vreg = *(const GAS v4u*)(Vg + goff + (size_t)(kt - 1) * 64 * DM); if (FOX && tid < 64) ckreg = CUM[(kt - 1) * 64 + tid]; }
        const bool active = !wdone && (k0 <= qmax);
        if (active) {
            const bool needmask = (k0 + 63 >= qmin);
            const LAS unsigned char* Kb = L + A0_K + buf * 8192; const LAS unsigned char* Vb = L + A0_V + buf * 8192;
            f32x16 p0, p1;
#pragma unroll
            for (int r = 0; r < 16; ++r) { p0[r] = 0.f; p1[r] = 0.f; }
#pragma unroll
            for (int ks = 0; ks < 4; ++ks) { const int ch = ((2 * ks + hi) ^ (r32 & 7)) * 16;
                const bf16x8 a0 = *(const LAS bf16x8*)(Kb + r32 * 128 + ch), a1 = *(const LAS bf16x8*)(Kb + (32 + r32) * 128 + ch);
                p0 = __builtin_amdgcn_mfma_f32_32x32x16_bf16(a0, qf[ks], p0, 0, 0, 0); p1 = __builtin_amdgcn_mfma_f32_32x32x16_bf16(a1, qf[ks], p1, 0, 0, 0); }
            if (FOX) {
                const LAS float* ckb = (const LAS float*)(L + A0_CK) + buf * 64;
#pragma unroll
                for (int g = 0; g < 4; ++g) { const f32x4 c0v = *(const LAS f32x4*)(ckb + 8 * g + 4 * hi), c1v = *(const LAS f32x4*)(ckb + 32 + 8 * g + 4 * hi);
#pragma unroll
                    for (int i = 0; i < 4; ++i) { p0[4 * g + i] += cq - c0v[i]; p1[4 * g + i] += cq - c1v[i]; } }
                if (needmask) {
#pragma unroll
                    for (int r = 0; r < 16; ++r) { const int key = k0 + crow(r, hi); if (key > tq) p0[r] = -INFINITY; if (key + 32 > tq) p1[r] = -INFINITY; } }
                float rm = fmaxf(p0[0], p1[0]);
#pragma unroll
                for (int r = 1; r < 16; ++r) rm = fmaxf(rm, fmaxf(p0[r], p1[r]));
                rm = fmaxf(rm, __shfl_xor(rm, 32));
                const float mnew = fmaxf(mrun, rm), alpha = __expf(mrun - mnew);
                float ps = 0.f;
#pragma unroll
                for (int r = 0; r < 16; ++r) { p0[r] = __expf(p0[r] - mnew); p1[r] = __expf(p1[r] - mnew); ps += p0[r] + p1[r]; }
                lrun = lrun * alpha + ps; mrun = mnew;
                if (__any(alpha != 1.f)) {
                    if (hi == 0) wsf[r32] = alpha;
                    __builtin_amdgcn_wave_barrier();
#pragma unroll
                    for (int r = 0; r < 16; ++r) { const float f = wsf[crow(r, hi)]; o0[r] *= f; o1[r] *= f; }
                    __builtin_amdgcn_wave_barrier();
                }
            } else {
                sb_sub(p1, k0 + 32, tq, hi, needmask, R);
                sb_sub(p0, k0, tq, hi, needmask, R);
            }
            const int vlane = ((lane >> 4) & 1) * 32 + (lane & 3) * 8, kq = 4 * hi + ((lane & 15) >> 2);
#pragma unroll
            for (int sub = 0; sub < 2; ++sub)
#pragma unroll
                for (int s = 0; s < 2; ++s) {
                    v4u pw;
                    if (sub == 0) { pw.x = cvtpk(p0[8 * s], p0[8 * s + 1]); pw.y = cvtpk(p0[8 * s + 2], p0[8 * s + 3]); pw.z = cvtpk(p0[8 * s + 4], p0[8 * s + 5]); pw.w = cvtpk(p0[8 * s + 6], p0[8 * s + 7]); }
                    else { pw.x = cvtpk(p1[8 * s], p1[8 * s + 1]); pw.y = cvtpk(p1[8 * s + 2], p1[8 * s + 3]); pw.z = cvtpk(p1[8 * s + 4], p1[8 * s + 5]); pw.w = cvtpk(p1[8 * s + 6], p1[8 * s + 7]); }
                    const bf16x8 pa = __builtin_bit_cast(bf16x8, pw);
                    const int key0 = 32 * sub + 16 * s + kq, sw = (key0 >> 1) & 1;
#pragma unroll
                    for (int db = 0; db < 2; ++db) {
                        const LAS unsigned char* va = Vb + key0 * 128 + ((db ^ sw) * 64) + vlane;
                        const s16x4 lo = vtr(va), hh = vtr(va + 8 * 128);
                        const bf16x8 vf = (bf16x8){lo[0], lo[1], lo[2], lo[3], hh[0], hh[1], hh[2], hh[3]};
                        if (db == 0) o0 = __builtin_amdgcn_mfma_f32_32x32x16_bf16(pa, vf, o0, 0, 0, 0); else o1 = __builtin_amdgcn_mfma_f32_32x32x16_bf16(pa, vf, o1, 0, 0, 0);
                    }
                }
        }
        if (!wdone) {
            if (!more) wdone = true;
            else if (FOX) { const float bound = qn * knmax + cq - CUM[k0 - 1]; wdone = __all(bound < mrun - 30.f); }
            else wdone = __all(R < -30.f);
        }
        LAS unsigned* flg = (LAS unsigned*)(L + A0_FLAG) + (kt & 1) * 8;
        if (lane == 0) flg[wave] = wdone ? 1u : 0u;
        if (more) { const int o = (buf ^ 1) * 8192; *(LAS v4u*)(L + kdst + o) = kreg; *(LAS v4u*)(L + vdst + o) = vreg; if (FOX && tid < 64) ((LAS float*)(L + A0_CK))[(buf ^ 1) * 64 + tid] = ckreg; }
        __syncthreads();
        if (!more) break;
        unsigned alld = 1u;
#pragma unroll
        for (int w = 0; w < 8; ++w) alld &= flg[w];
        if (alld) break;
        buf ^= 1;
    }
    float inv = 1.f;
    if (FOX) { const float lt = lrun + __shfl_xor(lrun, 32); inv = 1.f / lt; }
    if (hi == 0) wsf[r32] = inv;
    __builtin_amdgcn_wave_barrier();
#pragma unroll
    for (int r = 0; r < 16; ++r) { const float f = wsf[crow(r, hi)]; bf16* op = Og + (rowbase + qmin + crow(r, hi)) * DM + h * 64 + r32;
        op[0] = (bf16)f2bf(o0[r] * f); op[32] = (bf16)f2bf(o1[r] * f); }
    __syncthreads();
}
__device__ __forceinline__ void p2_attention(Frame& F) {
    for (int u = F.vcu; u < 512; u += F.G) attn0_unit<true>(F, u >> 8, 8 + ((u >> 5) & 7), u & 31);
    for (int u = F.vcu; u < 512; u += F.G) attn0_unit<false>(F, u >> 8, (u >> 5) & 7, u & 31);
}
constexpr int IX_CAP = 1024, IX_TRIG = IX_CAP - 256;
constexpr int IX_QS = 0, IX_SC = 36864, IX_ID = IX_SC + 16 * IX_CAP * 4, IX_CNT = IX_ID + 16 * IX_CAP * 2, IX_TAU = IX_CNT + 64;
static_assert(IX_TAU + 64 <= RING_BYTES, "indexer LDS");
__device__ __forceinline__ unsigned mono_key(float f) { const unsigned u = __float_as_uint(f); return (u & 0x80000000u) ? ~u : (u | 0x80000000u); }
__device__ __forceinline__ float mono_inv(unsigned k) { return __uint_as_float((k & 0x80000000u) ? (k & 0x7fffffffu) : ~k); }
__device__ __forceinline__ int wave_sum_dpp(int v) {
    v += __builtin_amdgcn_update_dpp(0, v, 0xB1, 0xF, 0xF, false);
    v += __builtin_amdgcn_update_dpp(0, v, 0x4E, 0xF, 0xF, false);
    v += __builtin_amdgcn_update_dpp(0, v, 0x141, 0xF, 0xF, false);
    v += __builtin_amdgcn_update_dpp(0, v, 0x140, 0xF, 0xF, false);
    return __builtin_amdgcn_readlane(v, 0) + __builtin_amdgcn_readlane(v, 16) + __builtin_amdgcn_readlane(v, 32) + __builtin_amdgcn_readlane(v, 48);
}
__device__ __forceinline__ float select256(LAS float* sc, LAS u16* id, int n, int lane_, bool exact, int* cnt_out) {
    constexpr int NE = IX_CAP / 64;
    const int lane = opaque(lane_), nl = n - lane;
    unsigned key[NE]; u16 idv[NE];
#pragma unroll
    for (int j = 0; j < NE; ++j) { const bool valid = 64 * j < nl; key[j] = valid ? mono_key(sc[lane + 64 * j]) : 0u; idv[j] = valid ? id[lane + 64 * j] : (u16)0; }
    unsigned T = 0u; int cntT = n; bool full = true;
#pragma unroll 1
    for (int bit = 31; bit >= 0; --bit) {
        const unsigned cand = T | (1u << bit); int tot = 0;
        unsigned long long mk[NE];
#pragma unroll
        for (int j = 0; j < NE; ++j) asm volatile("v_cmp_le_u32 %0, %1, %2" : "=s"(mk[j]) : "s"(cand), "v"(key[j]));
#pragma unroll
        for (int j = 0; j < NE; ++j) tot += __popcll(mk[j]);
        if (tot >= 256) { T = cand; cntT = tot; }
        if (!exact && bit <= 16 && bit > 0 && cntT <= 384 && T > 1u) { full = false; break; }
    }
    const unsigned Te = full ? T : T - 1u;
    int cg = 0, ce = 0;
#pragma unroll
    for (int j = 0; j < NE; ++j) { cg += (key[j] > Te) ? 1 : 0; ce += (key[j] == Te) ? 1 : 0; }
    int pk = cg | (ce << 16), inc = pk;
#pragma unroll
    for (int o = 1; o < 64; o <<= 1) { const int u = __shfl_up(inc, o); if (lane >= o) inc += u; }
    const int totp = __builtin_amdgcn_readlane(inc, 63), above = totp & 0xffff;
    const int kk = full ? 256 - above : 0;
    int pg = (inc - pk) & 0xffff, pe = (inc - pk) >> 16;
#pragma unroll
    for (int j = 0; j < NE; ++j) {
        const bool gt = key[j] > Te, eq = (key[j] == Te) && (pe < kk);
        if (gt) { sc[pg] = mono_inv(key[j]); id[pg] = idv[j]; }
        if (eq) { sc[above + pe] = mono_inv(key[j]); id[above + pe] = idv[j]; }
        pg += gt ? 1 : 0; pe += (key[j] == Te) ? 1 : 0;
    }
    *cnt_out = above + (kk > 0 ? kk : 0);
    return mono_inv(Te);
}
__device__ __forceinline__ void idx_unit(Frame& F, int b, int qg) {
    LAS unsigned char* L = F.lds + RING_OFF;
    const int tid = opaque(F.tid), lane = tid & 63, wave = F.wave, r32 = lane & 31, hi = lane >> 5, q = lane & 15, hsel = (lane >> 4) & 1;
    const size_t rowbase = (size_t)b * SEQ; const int t0 = qg * 16, nvis = ((t0 >> 6) + 1) * 64;
    const bf16* QI = (const bf16*)(F.ws + WS_QI); const bf16* KI = (const bf16*)(F.ws + WS_KI); const float* WI = (const float*)(F.ws + WS_WI); u16* IDX = (u16*)(F.ws + WS_IDX);
    LAS float* SC = (LAS float*)(L + IX_SC); LAS u16* ID = (LAS u16*)(L + IX_ID); LAS unsigned* CNT = (LAS unsigned*)(L + IX_CNT); LAS float* TAU = (LAS float*)(L + IX_TAU);
#pragma unroll
    for (int i = 0; i < 4; ++i) { const int ci = tid + 512 * i, qq = ci >> 7, rem = ci & 127, hh = rem >> 3, ch = rem & 7;
        *(LAS v4u*)(L + IX_QS + (hh * 16 + qq) * 144 + ch * 16) = *(const GAS v4u*)(QI + (rowbase + t0 + qq) * 1024 + hh * 64 + ch * 8); }
    if (tid < 16) { CNT[tid] = 0u; TAU[tid] = -INFINITY; }
    float wv[8];
#pragma unroll
    for (int hp = 0; hp < 8; ++hp) wv[hp] = WI[(rowbase + t0 + q) * 16 + 2 * hp + hsel];
    __syncthreads();
    bf16x8 afn[4];
#pragma unroll
    for (int ks = 0; ks < 4; ++ks) afn[ks] = *(const GAS bf16x8*)(KI + (rowbase + wave * 32 + r32) * 64 + 16 * ks + 8 * hi);
    for (int r0 = 0; r0 < nvis; r0 += 256) {
        const int kbase = r0 + wave * 32;
        bf16x8 af[4];
#pragma unroll
        for (int ks = 0; ks < 4; ++ks) af[ks] = afn[ks];
        if (kbase + 256 < nvis) {
#pragma unroll
            for (int ks = 0; ks < 4; ++ks) afn[ks] = *(const GAS bf16x8*)(KI + (rowbase + kbase + 256 + r32) * 64 + 16 * ks + 8 * hi); }
        if (kbase < nvis) {
            f32x16 acc;
#pragma unroll
            for (int r = 0; r < 16; ++r) acc[r] = 0.f;
#pragma unroll
            for (int hp = 0; hp < 8; hp += 2) {
                f32x16 c0, c1;
#pragma unroll
                for (int r = 0; r < 16; ++r) { c0[r] = 0.f; c1[r] = 0.f; }
                const LAS unsigned char* q0p = L + IX_QS + ((2 * hp + hsel) * 16 + q) * 144 + hi * 16;
                const LAS unsigned char* q1p = q0p + 2 * 16 * 144;
#pragma unroll
                for (int ks = 0; ks < 4; ++ks) { const bf16x8 b0 = *(const LAS bf16x8*)(q0p + ks * 32), b1 = *(const LAS bf16x8*)(q1p + ks * 32);
                    c0 = __builtin_amdgcn_mfma_f32_32x32x16_bf16(af[ks], b0, c0, 0, 0, 0); c1 = __builtin_amdgcn_mfma_f32_32x32x16_bf16(af[ks], b1, c1, 0, 0, 0); }
#pragma unroll
                for (int r = 0; r < 16; ++r) { const int i0 = __float_as_int(c0[r]), i1 = __float_as_int(c1[r]); const float y0 = __int_as_float(i0 > 0 ? i0 : 0), y1 = __int_as_float(i1 > 0 ? i1 : 0); acc[r] += wv[hp] * y0; acc[r] += wv[hp + 1] * y1; }
                __builtin_amdgcn_sched_barrier(0);
            }
#pragma unroll
            for (int r = 0; r < 16; ++r) acc[r] += __shfl_xor(acc[r], 16);
            const float tau = TAU[q];
            float sv[8]; int np = 0;
#pragma unroll
            for (int j = 0; j < 8; ++j) { sv[j] = hsel ? acc[8 + j] : acc[j]; np += (sv[j] > tau) ? 1 : 0; }
            if (np > 0) {
                unsigned pos = atomicAdd((unsigned*)(CNT + q), (unsigned)np);
                const int kb0 = kbase + 16 * hsel + 4 * hi;
#pragma unroll
                for (int j = 0; j < 8; ++j) if (sv[j] > tau) { SC[q * IX_CAP + pos] = sv[j]; ID[q * IX_CAP + pos] = (u16)(kb0 + (j & 3) + 8 * (j >> 2)); ++pos; }
            }
        }
        __syncthreads();
        unsigned mx = CNT[lane & 15];
#pragma unroll
        for (int o = 1; o < 16; o <<= 1) { const unsigned u = (unsigned)__shfl_xor((int)mx, o); mx = u > mx ? u : mx; }
        const bool last = r0 + 256 >= nvis;
        if (mx > (unsigned)IX_TRIG || last) {
#pragma unroll 1
            for (int qq = 2 * wave; qq < 2 * wave + 2; ++qq) { const int n = (int)CNT[qq];
                if (n > 256) { int nc; const float t = select256(SC + qq * IX_CAP, ID + qq * IX_CAP, n, lane, last, &nc); if (lane == 0) { CNT[qq] = (unsigned)nc; TAU[qq] = t; } } } }
        __syncthreads();
    }
    { const int qq = tid >> 5, n = (int)CNT[qq];
#pragma unroll
      for (int j = 0; j < 8; ++j) { const int i = (tid & 31) + 32 * j; IDX[(rowbase + t0 + qq) * 256 + i] = i < n ? ID[qq * IX_CAP + i] : (u16)0xFFFF; } }
    __syncthreads();
}
__device__ __forceinline__ void p10_indexer(Frame& F) {
    for (int i = 0; i < 1024; i += F.G) {
        const int s = i + F.vcu; if (s >= 1024) break;
        const int j = s >> 8, c = s & 255;
        const int v = (j == 0) ? c : (j == 1) ? 511 - c : (j == 2) ? 512 + c : 1023 - c;
        idx_unit(F, v & 1, v >> 1);
    }
}
constexpr int SP_ROWB = 544, SP_WAVE_BYTES = 32 * SP_ROWB;
static_assert(NWAVES * SP_WAVE_BYTES <= RING_BYTES, "sparse attention LDS");
__device__ __forceinline__ void sparse_query(Frame& F, int row) {
    const int lane = opaque(F.lane), r16 = lane & 15, g = lane >> 4, b = row >> 13, row8 = lane >> 3, p8 = lane & 7;
    LAS unsigned char* vb = F.lds + RING_OFF + F.wave * SP_WAVE_BYTES;
    const u16* ix = (const u16*)(F.ws + WS_IDX) + (size_t)row * 256;
    bf16* qrow = (bf16*)(F.ws + WS_QD) + (size_t)row * 4096;
    const bf16* KL = (const bf16*)(F.ws + WS_KL) + (size_t)b * SEQ * 256;
    bf16x8 qf[8];
#pragma unroll
    for (int ks = 0; ks < 8; ++ks) qf[ks] = *(const GAS bf16x8*)(qrow + r16 * 256 + 32 * ks + 8 * g);
    f32x4 ctx[12];
#pragma unroll
    for (int ct = 0; ct < 12; ++ct) ctx[ct] = (f32x4){0.f, 0.f, 0.f, 0.f};
    float mrun = -INFINITY, lrun = 0.f;
    const int trd = (4 * g + (r16 >> 2)) * SP_ROWB + 128 + (r16 & 3) * 8;
    v4u gr[4][4];
#define SP_GATHER(s_) do { _Pragma("unroll") for (int i_ = 0; i_ < 4; ++i_) { const unsigned key_ = ix[32 * (s_) + 8 * i_ + row8]; \
        const bf16* kp_ = KL + (size_t)(key_ == 0xFFFFu ? 0u : key_) * 256 + 8 * p8; \
        _Pragma("unroll") for (int c_ = 0; c_ < 4; ++c_) gr[i_][c_] = *(const GAS v4u*)(kp_ + 64 * c_); } } while (0)
    SP_GATHER(0);
#pragma unroll 1
    for (int s = 0; s < 8; ++s) {
#pragma unroll
        for (int i = 0; i < 4; ++i)
#pragma unroll
            for (int c = 0; c < 4; ++c) *(LAS v4u*)(vb + (8 * i + row8) * SP_ROWB + c * 128 + p8 * 16) = gr[i][c];
        if (s < 7) SP_GATHER(s + 1);
        f32x4 S0 = (f32x4){0.f, 0.f, 0.f, 0.f}, S1 = S0;
#pragma unroll
        for (int ks = 0; ks < 8; ++ks) {
            const bf16x8 a0 = *(const LAS bf16x8*)(vb + r16 * SP_ROWB + (32 * ks + 8 * g) * 2), a1 = *(const LAS bf16x8*)(vb + (16 + r16) * SP_ROWB + (32 * ks + 8 * g) * 2);
            S0 = __builtin_amdgcn_mfma_f32_16x16x32_bf16(a0, qf[ks], S0, 0, 0, 0); S1 = __builtin_amdgcn_mfma_f32_16x16x32_bf16(a1, qf[ks], S1, 0, 0, 0);
        }
        const v2u i0 = *(const GAS v2u*)(ix + 32 * s + 4 * g), i1 = *(const GAS v2u*)(ix + 32 * s + 16 + 4 * g);
        float x[8];
        x[0] = (i0.x & 0xffffu) == 0xffffu ? -INFINITY : S0[0] * DSA_SCALE; x[1] = (i0.x >> 16) == 0xffffu ? -INFINITY : S0[1] * DSA_SCALE;
        x[2] = (i0.y & 0xffffu) == 0xffffu ? -INFINITY : S0[2] * DSA_SCALE; x[3] = (i0.y >> 16) == 0xffffu ? -INFINITY : S0[3] * DSA_SCALE;
        x[4] = (i1.x & 0xffffu) == 0xffffu ? -INFINITY : S1[0] * DSA_SCALE; x[5] = (i1.x >> 16) == 0xffffu ? -INFINITY : S1[1] * DSA_SCALE;
        x[6] = (i1.y & 0xffffu) == 0xffffu ? -INFINITY : S1[2] * DSA_SCALE; x[7] = (i1.y >> 16) == 0xffffu ? -INFINITY : S1[3] * DSA_SCALE;
        float cm = fmaxf(fmaxf(fmaxf(x[0], x[1]), fmaxf(x[2], x[3])), fmaxf(fmaxf(x[4], x[5]), fmaxf(x[6], x[7])));
        cm = fmaxf(cm, __shfl_xor(cm, 16)); cm = fmaxf(cm, __shfl_xor(cm, 32));
        const float mnew = fmaxf(mrun, cm), alpha = __expf(mrun - mnew);
        float ps = 0.f;
#pragma unroll
        for (int i = 0; i < 8; ++i) { x[i] = __expf(x[i] - mnew); ps += x[i]; }
        lrun = lrun * alpha + ps; mrun = mnew;
        if (__any(alpha != 1.f)) {
#pragma unroll
            for (int ct = 0; ct < 12; ++ct) ctx[ct] = ctx[ct] * alpha; }
        const v4u pw = (v4u){cvtpk(x[0], x[1]), cvtpk(x[2], x[3]), cvtpk(x[4], x[5]), cvtpk(x[6], x[7])};
        const bf16x8 pf = __builtin_bit_cast(bf16x8, pw);
#pragma unroll
        for (int ct = 0; ct < 12; ++ct) {
            const s16x4 lo = vtr(vb + trd + ct * 32), hh = vtr(vb + trd + 16 * SP_ROWB + ct * 32);
            const bf16x8 vf = (bf16x8){lo[0], lo[1], lo[2], lo[3], hh[0], hh[1], hh[2], hh[3]};
            ctx[ct] = __builtin_amdgcn_mfma_f32_16x16x32_bf16(vf, pf, ctx[ct], 0, 0, 0);
        }
    }
#undef SP_GATHER
    lrun += __shfl_xor(lrun, 16); lrun += __shfl_xor(lrun, 32);
    const float inv = 1.f / lrun;
#pragma unroll
    for (int ct = 0; ct < 12; ++ct) { const f32x4 v = ctx[ct] * inv; *(GAS v2u*)(qrow + r16 * 192 + 16 * ct + 4 * g) = (v2u){cvtpk(v[0], v[1]), cvtpk(v[2], v[3])}; }
}
__device__ __forceinline__ void p11_sparse(Frame& F) {
    const int gw = F.vcu * NWAVES + F.wave, NGW = F.G * NWAVES;
    for (int row = gw; row < M; row += NGW) sparse_query(F, row);
}
constexpr int REP_P0 = 1, REP_P2 = 1, REP_P10 = 1;
__global__ void __launch_bounds__(NWAVES * 64, 2) mk_fwd(Args args) {
    extern __shared__ __attribute__((aligned(16))) unsigned char lds[];
    Frame F;
    F.lds = (LAS unsigned char*)lds;
    F.MISC = (volatile LAS unsigned*)(F.lds + MISC_OFF);
    F.tid = threadIdx.x; F.lane = F.tid & 63; F.wave = __builtin_amdgcn_readfirstlane(F.tid >> 6);
    F.G = gridDim.x; { const int bx = blockIdx.x; F.vcu = (F.G % 8 == 0) ? (bx % 8) * (F.G / 8) + bx / 8 : bx; }
    F.ws = args.ws; F.out = args.out; F.ctl = (gu32*)(args.ws + WS_CTL);
    for (int u = F.tid; u < (LDS_BYTES - LDSCTL_OFF) / 4; u += NWAVES * 64) ((LAS unsigned*)(F.lds + LDSCTL_OFF))[u] = 0u;
    __syncthreads();
    XcdBarrier bar = xcd_barrier_post((unsigned*)(F.ctl + CW_BAR), F.MISC + 8);
#define GRID_BAR() xcd_barrier(bar)
    unsigned char* ws = args.ws;
    bf16* XB = (bf16*)(ws + WS_XB); bf16* HB = (bf16*)(ws + WS_H);
    const int bx = (int)blockIdx.x;

    for (int rep = 0; rep < REP_P0; ++rep) p0_prologue(F);
    GRID_BAR();
    {   pg8::Gemm g{XB, (const bf16*)(ws + WS_W0IN), M, NQKV0, DM, DM}; pg8::StaticOrder S; S.init(M, NQKV0, F.G, bx);
        pg8::EpiBf16<0> E{(bf16*)(ws + WS_QO), DM, nullptr, DM, (size_t)(WS_K - WS_QO) / 2, 0.125f};
        pg8::gemm_phase<pg8::EpiBf16<0>, pg8::StaticOrder, PG8_ALIGN, PG8_SP2>(F.lds + RING_OFF, g, S, E); }
    GRID_BAR();
    p1b_scan_kn(F);
    GRID_BAR();
    for (int rep = 0; rep < REP_P2; ++rep) p2_attention(F);
    GRID_BAR();
    {   pg8::Gemm g{XB, (const bf16*)(ws + WS_W0O), M, DM, DM, DM}; pg8::StaticOrder S; S.init(M, DM, F.G, bx);
        pg8::EpiResF32 E{argp(0), F.out, DM, ALPHA};
        pg8::gemm_phase<pg8::EpiResF32, pg8::StaticOrder, PG8_ALIGN, PG8_SP2>(F.lds + RING_OFF, g, S, E); }
    GRID_BAR();
    ln_phase(F, F.out, argp(5), argp(6), XB);
    GRID_BAR();
    {   pg8::Gemm g{XB, (const bf16*)(ws + WS_W0UP), M, FF2, DM, DM}; pg8::StaticOrder S; S.init(M, FF2, F.G, bx);
        pg8::EpiBf16<0> E{HB, FF2, nullptr, 0, 0, 1.f};
        pg8::gemm_phase<pg8::EpiBf16<0>, pg8::StaticOrder, PG8_ALIGN, PG8_SP2>(F.lds + RING_OFF, g, S, E); }
    GRID_BAR();
    conv_phase(F, HB, argp(8), argp(9));
    GRID_BAR();
    {   pg8::Gemm g{HB + FF, (const bf16*)(ws + WS_W0DN), M, DM, FF, FF2}; pg8::StaticOrder S; S.init(M, DM, F.G, bx);
        pg8::EpiResF32 E{F.out, F.out, DM, ALPHA};
        pg8::gemm_phase<pg8::EpiResF32, pg8::StaticOrder, PG8_ALIGN, PG8_SP2>(F.lds + RING_OFF, g, S, E); }
    GRID_BAR();
    ln_phase(F, F.out, argp(11), argp(12), XB);
    p8_prep(F);
    GRID_BAR();
    {   pg8::Gemm g{XB, (const bf16*)(ws + WS_W1IN), M, N1PAD, DM, DM}; pg8::StaticOrder S; S.init(M, N1PAD, F.G, bx);
        pg8::EpiL1In E{(bf16*)(ws + WS_QD), (bf16*)(ws + WS_KL), (bf16*)(ws + WS_QI), (bf16*)(ws + WS_KI), (float*)(ws + WS_WI), (const float*)(ws + WS_CSQ), (const float*)(ws + WS_CSI), IDX_SCALE};
        pg8::gemm_phase<pg8::EpiL1In, pg8::StaticOrder, PG8_ALIGN, PG8_SP2>(F.lds + RING_OFF, g, S, E); }
    GRID_BAR();
    for (int rep = 0; rep < REP_P10; ++rep) p10_indexer(F);
    GRID_BAR();
    p11_sparse(F);
    GRID_BAR();
    {   pg8::Gemm g{(const bf16*)(ws + WS_QD), (const bf16*)(ws + WS_WC), M, DM, 3072, 4096}; pg8::StaticOrder S; S.init(M, DM, F.G, bx);
        pg8::EpiResF32 E{F.out, F.out, DM, ALPHA};
        pg8::gemm_phase<pg8::EpiResF32, pg8::StaticOrder, PG8_ALIGN, PG8_SP2>(F.lds + RING_OFF, g, S, E); }
    GRID_BAR();
    ln_phase(F, F.out, argp(16), argp(17), XB);
    GRID_BAR();
    {   pg8::Gemm g{XB, (const bf16*)(ws + WS_W1UP), M, FF2, DM, DM}; pg8::StaticOrder S; S.init(M, FF2, F.G, bx);
        pg8::EpiBf16<0> E{HB, FF2, nullptr, 0, 0, 1.f};
        pg8::gemm_phase<pg8::EpiBf16<0>, pg8::StaticOrder, PG8_ALIGN, PG8_SP2>(F.lds + RING_OFF, g, S, E); }
    GRID_BAR();
    conv_phase(F, HB, argp(19), argp(20));
    GRID_BAR();
    {   pg8::Gemm g{HB + FF, (const bf16*)(ws + WS_W1DN), M, DM, FF, FF2}; pg8::StaticOrder S; S.init(M, DM, F.G, bx);
        pg8::EpiResF32 E{F.out, F.out, DM, ALPHA};
        pg8::gemm_phase<pg8::EpiResF32, pg8::StaticOrder, PG8_ALIGN, PG8_SP2>(F.lds + RING_OFF, g, S, E); }
    GRID_BAR();
    ln_phase(F, F.out, argp(22), argp(23), nullptr);
#undef GRID_BAR
}

extern "C" void kernel_launch(void* const* d_in, const int* in_sizes, int n_in, void* d_out, int out_size, void* d_ws, size_t ws_size, hipStream_t stream) {
    static int grid = 0;
    if (grid == 0) {
        if (n_in != NIN || in_sizes[0] != M * DM || out_size != M * DM || ws_size < WS_END) { fprintf(stderr, "kernel_launch: unexpected shapes (n_in %d, in0 %d, out %d, ws %zu); nothing launched\n", n_in, n_in > 0 ? in_sizes[0] : -1, out_size, ws_size); grid = -1; return; }
        int dev = 0, cus = 0, per_cu = 0;
        if (hipGetDevice(&dev) != hipSuccess || hipDeviceGetAttribute(&cus, hipDeviceAttributeMultiprocessorCount, dev) != hipSuccess) { grid = -1; return; }
        if (hipFuncSetAttribute((const void*)mk_fwd, hipFuncAttributeMaxDynamicSharedMemorySize, LDS_BYTES) != hipSuccess) { fprintf(stderr, "kernel_launch: hipFuncSetAttribute failed\n"); grid = -1; return; }
        if (hipOccupancyMaxActiveBlocksPerMultiprocessor(&per_cu, (const void*)mk_fwd, NWAVES * 64, LDS_BYTES) != hipSuccess || per_cu < 1) fprintf(stderr, "kernel_launch: occupancy query reports %d workgroups per CU\n", per_cu);
        (void)hipGetLastError();
        grid = cus;
    }
    if (grid < 0) return;
    if (hipMemsetAsync((char*)d_ws + WS_CTL, 0, CTL_ZERO_BYTES, stream) != hipSuccess) { fprintf(stderr, "kernel_launch: hipMemsetAsync failed\n"); return; }
    Args a{};
    for (int i = 0; i < NIN; ++i) a.in[i] = (const float*)d_in[i];
    a.out = (float*)d_out; a.ws = (unsigned char*)d_ws;
    hipLaunchKernelGGL(mk_fwd, dim3(grid), dim3(NWAVES * 64), LDS_BYTES, stream, a);
    const hipError_t le = hipPeekAtLastError();
    if (le != hipSuccess) fprintf(stderr, "kernel_launch: launch failed: %s\n", hipGetErrorName(le));
}
```

```cpp
#include <hip/hip_runtime.h>
#include <cstdio>
#include <cstdint>
namespace pg8 {
#define PG8_LAS __attribute__((address_space(3)))
typedef unsigned short bf16_t;
typedef short bf16x8 __attribute__((ext_vector_type(8)));
typedef float f32x4 __attribute__((ext_vector_type(4)));
typedef unsigned u32x4 __attribute__((ext_vector_type(4)));
constexpr int BM = 256, BK = 64, HALF = 128, HTB = HALF * BK * 2  , STAGE_BYTES = 8 * HTB, NXCD = 8, WGM = 8;

__host__ __device__ __forceinline__ int lds_byte(int r, int c) { const int st = (r >> 4) * 2 + (c >> 5), rr = r & 15, cc = c & 31, ob = rr * 64 + cc * 2; return st * 1024 + (ob ^ (((ob >> 9) & 1) << 5)); }
__host__ __device__ __forceinline__ void stage_rc(int b, int& R, int& C) { const int st = b / 1024, sb = b % 1024, swz = sb ^ (((sb >> 9) & 1) << 5); R = (st >> 1) * 16 + swz / 64; C = (st & 1) * 32 + (swz % 64) / 2; }
__host__ __device__ __forceinline__ int perm32(int rho) { const int n = rho >> 4, i = rho & 15; return 8 * (i >> 2) + 4 * n + (i & 3); }

struct Unit { int pm, pn; };
struct Gemm { const bf16_t* A; const bf16_t* Bt; int M, N, K, lda; };

struct StaticOrder {
    int nM, nN, nwg, G, c;
    __host__ __device__ void init(int M, int N, int G_, int c_) { nM = M / BM; nN = N / BM; nwg = nM * nN; G = G_; c = c_; }
    __host__ __device__ bool next(int i, Unit& u) const {
        const long L = (long)i * G + c; if (L >= nwg) return false;
        int wgid = (int)L; { const int q = nwg / NXCD, r = nwg % NXCD, xcd = wgid % NXCD, off = wgid / NXCD; wgid = (xcd < r ? xcd * (q + 1) : r * (q + 1) + (xcd - r) * q) + off; }
        const int nig = WGM * nN, gid = wgid / nig, fm = gid * WGM, gsz = (nM - fm) < WGM ? (nM - fm) : WGM;
        u.pm = fm + ((wgid % nig) % gsz); u.pn = (wgid % nig) / gsz; return true;
    }
    __device__ __forceinline__ int arow(const Unit& u) const { return u.pm * BM; }
    __device__ __forceinline__ void a_ready(const Unit&) const {}
    __device__ __forceinline__ void done(const Unit&) const {}
};
struct HaloOrder : StaticOrder {
    __host__ __device__ void init(int nM_, int N, int G_, int c_) { nM = nM_; nN = N / BM; nwg = nM * nN; G = G_; c = c_; }
    __device__ __forceinline__ int arow(const Unit& u) const { return u.pm * 254; }
};

__device__ __forceinline__ unsigned cvt_pk_bf16(float lo, float hi) { unsigned r; asm volatile("v_cvt_pk_bf16_f32 %0, %1, %2" : "=v"(r) : "v"(lo), "v"(hi)); return r; }
typedef float f32x2 __attribute__((ext_vector_type(2)));
__device__ __forceinline__ f32x2 gelu_pk(f32x2 v) {
    const f32x2 av = __builtin_elementwise_abs(v), d = av * 0.2316418882f + 1.0f;
    f32x2 t; t.x = __builtin_amdgcn_rcpf(d.x); t.y = __builtin_amdgcn_rcpf(d.y);
    f32x2 q = t * 0.5307027145f + (-0.7265760135f); q = q * t + 0.7107068705f; q = q * t + (-0.142248368f); q = q * t + 0.127414796f; q = q * t;
    const f32x2 s = (v * v) * (-0.72134752044f);
    f32x2 e; e.x = __builtin_amdgcn_exp2f(s.x); e.y = __builtin_amdgcn_exp2f(s.y);
    const f32x2 m = v * (q * e), r = v - m;
    f32x2 o; o.x = v.x < 0.f ? m.x : r.x; o.y = v.y < 0.f ? m.y : r.y; return o;
}

template <int ACT  > struct EpiBf16 {
    static constexpr bool PERM = true, AFTER_DRAIN = false; static_assert(ACT == 0 || ACT == 1, "EpiBf16: ACT is 0 (none) or 1 (gelu_pk)");
    bf16_t* O; int ldc; const float* bias; int split_cols; size_t split_stride; float scale0;
    __device__ __forceinline__ void operator()(const f32x4 (&acc)[2][2][4][2], const Unit& u, int wr, int wc, int fr, int fq) const {
        const int row0 = u.pm * BM + wr * 64 + fr; int colt = u.pn * BM; bf16_t* base = O;
        float sc = 1.f; if (split_cols) { const int t = colt / split_cols; base += (size_t)t * split_stride; colt -= t * split_cols; if (t == 0) sc = scale0; }
        const int col0 = colt + wc * 32 + 8 * fq, bcol0 = u.pn * BM + wc * 32 + 8 * fq;
        f32x4 bv[2][2];
#pragma unroll
        for (int bj = 0; bj < 2; ++bj)
#pragma unroll
            for (int n = 0; n < 2; ++n) bv[bj][n] = bias ? *(const f32x4*)(bias + bcol0 + bj * HALF + 4 * n) : (f32x4){0.f, 0.f, 0.f, 0.f};
#pragma unroll
        for (int ai = 0; ai < 2; ++ai)
#pragma unroll
            for (int m = 0; m < 4; ++m) { bf16_t* rowp = base + (size_t)(row0 + ai * HALF + m * 16) * ldc + col0;
#pragma unroll
                for (int bj = 0; bj < 2; ++bj) { f32x4 v0 = acc[ai][bj][m][0] + bv[bj][0], v1 = acc[ai][bj][m][1] + bv[bj][1];
                    if (ACT == 1) { f32x2 a = gelu_pk((f32x2){v0[0], v0[1]}), b = gelu_pk((f32x2){v0[2], v0[3]}), c = gelu_pk((f32x2){v1[0], v1[1]}), d = gelu_pk((f32x2){v1[2], v1[3]});
                        v0 = (f32x4){a.x, a.y, b.x, b.y}; v1 = (f32x4){c.x, c.y, d.x, d.y}; }
                    v0 = v0 * sc; v1 = v1 * sc; u32x4 w; w.x = cvt_pk_bf16(v0[0], v0[1]); w.y = cvt_pk_bf16(v0[2], v0[3]); w.z = cvt_pk_bf16(v1[0], v1[1]); w.w = cvt_pk_bf16(v1[2], v1[3]);
                    *(u32x4*)(rowp + bj * HALF) = w; } }
    }
};
template <class Epi, class Sched, bool ALIGN_EPI = false, bool SP2 = false>
__device__ __forceinline__ void gemm_phase(PG8_LAS unsigned char* lds, const Gemm g, const Sched& S, const Epi& E) {
    int tid_ = threadIdx.x; asm volatile("" : "+v"(tid_));
    const int tid = tid_, wid = __builtin_amdgcn_readfirstlane(tid >> 6), lane = tid & 63, wr = wid >> 2, wc = wid & 3, fr = lane & 15, fq = lane >> 4;
    const int K = g.K, nt = K / BK;
    unsigned voffA[2], voffB[2];
#pragma unroll
    for (int i = 0; i < 2; ++i) { int R, C; stage_rc(tid * 16 + i * 8192, R, C); const int Rb = Epi::PERM ? ((R & ~31) + perm32(R & 31)) : R;
        voffA[i] = (unsigned)(R * g.lda + C) * 2u; voffB[i] = (unsigned)(Rb * K + C) * 2u; }
    const size_t kstep = (size_t)(BK * 2);
    const size_t hstepB = (size_t)HALF * K * 2, hstepA = (size_t)HALF * g.lda * 2;
    const size_t rowA = (size_t)g.lda * 2, tstepB = 2 * hstepB;
    const unsigned ldsw = (unsigned)wid * 1024u;
    const int aoff = lds_byte(wr * 64 + fr, fq * 8), boff = lds_byte(wc * 32 + fr, fq * 8);
#define PG8_SA(b, h) (((b) * 2 + (h)) * HTB)
#define PG8_SB(b, h) ((4 + (b) * 2 + (h)) * HTB)
#define PG8_STAGE(bufoff, gbase, voff) do { _Pragma("unroll") for (int _i = 0; _i < 2; ++_i) \
        __builtin_amdgcn_global_load_lds((const unsigned*)((const char*)(gbase) + (voff)[_i]), (PG8_LAS unsigned*)(lds + (bufoff) + ldsw + _i * 8192), 16, 0, 0); } while (0)
#define PG8_LDA(dst, b, h) do { _Pragma("unroll") for (int m = 0; m < 4; ++m) _Pragma("unroll") for (int k = 0; k < 2; ++k) dst[m][k] = *(const PG8_LAS bf16x8*)(lds + PG8_SA(b, h) + aoff + m * 2048 + k * 1024); } while (0)
#define PG8_LDB(dst, b, h) do { _Pragma("unroll") for (int n = 0; n < 2; ++n) _Pragma("unroll") for (int k = 0; k < 2; ++k) dst[n][k] = *(const PG8_LAS bf16x8*)(lds + PG8_SB(b, h) + boff + n * 2048 + k * 1024); } while (0)
#define PG8_MMA(ai, bj, At, Bt) do { __builtin_amdgcn_s_setprio(1); _Pragma("unroll") for (int m = 0; m < 4; ++m) _Pragma("unroll") for (int n = 0; n < 2; ++n) _Pragma("unroll") for (int k = 0; k < 2; ++k) \
        acc[ai][bj][m][n] = __builtin_amdgcn_mfma_f32_16x16x32_bf16(Bt[n][k], At[m][k], acc[ai][bj][m][n], 0, 0, 0); __builtin_amdgcn_s_setprio(0); } while (0)
#define PG8_WAIT_V(n) asm volatile("s_waitcnt vmcnt(" #n ")" ::: "memory")
#define PG8_WAIT_L(n) asm volatile("s_waitcnt lgkmcnt(" #n ")" ::: "memory")
#define PG8_BAR __builtin_amdgcn_s_barrier()
#define PG8_SCHED __builtin_amdgcn_sched_barrier(0)
    Unit cur, nxt; int ui = 0;
    if (!S.next(0, cur)) return;
    f32x4 acc[2][2][4][2];
#pragma unroll
    for (int a = 0; a < 2; ++a)
#pragma unroll
        for (int b = 0; b < 2; ++b)
#pragma unroll
            for (int m = 0; m < 4; ++m)
#pragma unroll
                for (int n = 0; n < 2; ++n) acc[a][b][m][n] = (f32x4){0.f, 0.f, 0.f, 0.f};
    bf16x8 At[4][2], B0[2][2], B1[2][2];
    const char* cA = (const char*)g.A + (size_t)S.arow(cur) * rowA; const char* cB = (const char*)g.Bt + (size_t)cur.pn * tstepB;
    S.a_ready(cur);
    if constexpr (SP2) {
        PG8_STAGE(PG8_SB(0, 0), cB, voffB); PG8_STAGE(PG8_SB(0, 1), cB + hstepB, voffB); PG8_STAGE(PG8_SA(0, 0), cA, voffA); PG8_STAGE(PG8_SA(0, 1), cA + hstepA, voffA);
        if (wr == 1) PG8_BAR;
        PG8_WAIT_V(2); PG8_BAR;
        PG8_STAGE(PG8_SB(1, 0), cB + kstep, voffB); PG8_STAGE(PG8_SA(1, 0), cA + kstep, voffA); PG8_STAGE(PG8_SB(1, 1), cB + hstepB + kstep, voffB);
        PG8_WAIT_V(6); PG8_BAR;
    } else {
        PG8_STAGE(PG8_SB(0, 0), cB, voffB); PG8_STAGE(PG8_SA(0, 0), cA, voffA); PG8_STAGE(PG8_SB(0, 1), cB + hstepB, voffB); PG8_STAGE(PG8_SA(0, 1), cA + hstepA, voffA);
        if (wr == 1) PG8_BAR;
        PG8_WAIT_V(4); PG8_BAR;
        PG8_STAGE(PG8_SB(1, 0), cB + kstep, voffB); PG8_STAGE(PG8_SA(1, 0), cA + kstep, voffA); PG8_STAGE(PG8_SB(1, 1), cB + hstepB + kstep, voffB);
        PG8_WAIT_V(6); PG8_BAR;
    }
    for (;;) {
        const bool has_next = S.next(ui + 1, nxt);
        const char* nA = has_next ? (const char*)g.A + (size_t)S.arow(nxt) * rowA : cA; const char* nB = has_next ? (const char*)g.Bt + (size_t)nxt.pn * tstepB : cB;
        for (int t = 0; t < nt; t += 2) {
            const bool last = (t == nt - 2);
            const char* a1 = cA + (size_t)(t + 1) * kstep;
            const char* a2 = last ? nA : cA + (size_t)(t + 2) * kstep; const char* b2 = last ? nB : cB + (size_t)(t + 2) * kstep;
            const char* a3 = a2 + kstep; const char* b3 = b2 + kstep;
            if (last && has_next) S.a_ready(nxt);
            if constexpr (SP2) {
            PG8_LDB(B0, 0, 0); PG8_LDB(B1, 0, 1); PG8_SCHED; PG8_LDA(At, 0, 0); PG8_STAGE(PG8_SA(1, 1), a1 + hstepA, voffA);
            PG8_WAIT_V(8); PG8_WAIT_L(0); PG8_BAR; PG8_MMA(0, 0, At, B0); PG8_MMA(0, 1, At, B1); PG8_BAR; PG8_SCHED;
            PG8_LDA(At, 0, 1); PG8_STAGE(PG8_SB(0, 0), b2, voffB); PG8_STAGE(PG8_SB(0, 1), b2 + hstepB, voffB); PG8_STAGE(PG8_SA(0, 0), a2, voffA);
            PG8_WAIT_V(8); PG8_WAIT_L(0); PG8_BAR; PG8_MMA(1, 0, At, B0); PG8_MMA(1, 1, At, B1); PG8_BAR; PG8_SCHED;
            PG8_LDB(B0, 1, 0); PG8_LDB(B1, 1, 1); PG8_SCHED; PG8_LDA(At, 1, 0); PG8_STAGE(PG8_SA(0, 1), a2 + hstepA, voffA);
            PG8_WAIT_V(8); PG8_WAIT_L(0); PG8_BAR; PG8_MMA(0, 0, At, B0); PG8_MMA(0, 1, At, B1); PG8_BAR; PG8_SCHED;
            PG8_LDA(At, 1, 1); PG8_STAGE(PG8_SB(1, 0), b3, voffB); PG8_STAGE(PG8_SB(1, 1), b3 + hstepB, voffB); PG8_STAGE(PG8_SA(1, 0), a3, voffA);
            PG8_WAIT_V(8); PG8_WAIT_L(0); PG8_BAR; PG8_MMA(1, 0, At, B0); PG8_MMA(1, 1, At, B1); PG8_BAR; PG8_SCHED;
            } else {
            PG8_LDB(B0, 0, 0); PG8_SCHED; PG8_LDA(At, 0, 0); PG8_STAGE(PG8_SA(1, 1), a1 + hstepA, voffA);
            PG8_WAIT_L(8); PG8_BAR; PG8_WAIT_L(0); PG8_MMA(0, 0, At, B0); PG8_BAR; PG8_SCHED;
            PG8_LDB(B1, 0, 1); PG8_STAGE(PG8_SB(0, 0), b2, voffB);
            PG8_BAR; PG8_WAIT_L(0); PG8_MMA(0, 1, At, B1); PG8_BAR;
            PG8_LDA(At, 0, 1); PG8_STAGE(PG8_SA(0, 0), a2, voffA);
            PG8_BAR; PG8_WAIT_L(0); PG8_MMA(1, 0, At, B0); PG8_BAR; PG8_SCHED;
            PG8_STAGE(PG8_SB(0, 1), b2 + hstepB, voffB);
            PG8_WAIT_V(6); PG8_BAR; PG8_MMA(1, 1, At, B1); PG8_BAR;
            PG8_LDB(B0, 1, 0); PG8_SCHED; PG8_LDA(At, 1, 0); PG8_STAGE(PG8_SA(0, 1), a2 + hstepA, voffA);
            PG8_WAIT_L(8); PG8_BAR; PG8_WAIT_L(0); PG8_MMA(0, 0, At, B0); PG8_BAR; PG8_SCHED;
            PG8_LDB(B1, 1, 1); PG8_STAGE(PG8_SB(1, 0), b3, voffB);
            PG8_BAR; PG8_WAIT_L(0); PG8_MMA(0, 1, At, B1); PG8_BAR;
            PG8_LDA(At, 1, 1); PG8_STAGE(PG8_SA(1, 0), a3, voffA);
            PG8_BAR; PG8_WAIT_L(0); PG8_MMA(1, 0, At, B0); PG8_BAR; PG8_SCHED;
            PG8_STAGE(PG8_SB(1, 1), b3 + hstepB, voffB);
            PG8_WAIT_V(6); PG8_BAR; PG8_MMA(1, 1, At, B1); PG8_BAR;
            }
        }
        if constexpr (ALIGN_EPI) { if (wr == 0) PG8_BAR; }
        if constexpr (!Epi::AFTER_DRAIN) { E(acc, cur, wr, wc, fr, fq); S.done(cur); }
        if (!has_next) break;
#pragma unroll
        for (int a = 0; a < 2; ++a)
#pragma unroll
            for (int b = 0; b < 2; ++b)
#pragma unroll
                for (int m = 0; m < 4; ++m)
#pragma unroll
                    for (int n = 0; n < 2; ++n) acc[a][b][m][n] = (f32x4){0.f, 0.f, 0.f, 0.f};
        cur = nxt; cA = nA; cB = nB; ++ui;
        if constexpr (ALIGN_EPI) { if (wr == 1) PG8_BAR; }
    }
    PG8_WAIT_V(0);
    if constexpr (!ALIGN_EPI) { if (wr == 0) PG8_BAR; }
    PG8_BAR;
    if constexpr (Epi::AFTER_DRAIN) { E.fused(acc, cur, wr, wc, fr, fq, lds, wid, lane); S.done(cur); }
#undef PG8_SA
#undef PG8_SB
#undef PG8_STAGE
#undef PG8_LDA
#undef PG8_LDB
#undef PG8_MMA
#undef PG8_WAIT_V
#undef PG8_WAIT_L
#undef PG8_BAR
#undef PG8_SCHED
}
}

#ifndef PG8_SP2
#define PG8_SP2 true
#endif
#ifndef PG8_ALIGN
#define PG8_ALIGN true
#endif
namespace pg8 {
struct EpiResF32 {
    static constexpr bool PERM = false, AFTER_DRAIN = false;
    const float* base; float* out; int ldc; float alpha;
    __device__ __forceinline__ void operator()(const f32x4 (&acc)[2][2][4][2], const Unit& u, int wr, int wc, int fr, int fq) const {
        const int col0 = u.pn * BM + wc * 32 + 4 * fq;
#pragma unroll
        for (int ai = 0; ai < 2; ++ai)
#pragma unroll
            for (int m = 0; m < 4; ++m) { const size_t off = (size_t)(u.pm * BM + ai * HALF + wr * 64 + m * 16 + fr) * ldc + col0;
#pragma unroll
                for (int bj = 0; bj < 2; ++bj)
#pragma unroll
                    for (int n = 0; n < 2; ++n) { const f32x4 bs = *(const f32x4*)(base + off + bj * HALF + n * 16); *(f32x4*)(out + off + bj * HALF + n * 16) = bs * alpha + acc[ai][bj][m][n]; }
                asm volatile("" ::: "memory"); }
    }
};
struct EpiL1In {
    static constexpr bool PERM = true, AFTER_DRAIN = false;
    bf16_t *Qd, *KL, *QI, *KI; float* WI; const float* csq; const float* csi; float wscale;
    __device__ __forceinline__ void operator()(const f32x4 (&acc)[2][2][4][2], const Unit& u, int wr, int wc, int fr, int fq) const {
        const int pn = u.pn, row0 = u.pm * BM + wr * 64 + fr;
#pragma unroll
        for (int bj = 0; bj < 2; ++bj) {
            const int c0 = bj * HALF + wc * 32 + 8 * fq;
            int kind = 0, pb = 0, ld = 0, dcol = 0; bf16_t* dst = nullptr; bool f32out = false, skip = false;
            if (pn < 16) { dst = Qd; ld = 4096; dcol = pn * 256 + c0; kind = c0 < 64 ? 1 : 0; pb = c0 >> 1; }
            else if (pn == 16) { dst = KL; ld = 256; dcol = c0; kind = c0 < 64 ? 1 : 0; pb = c0 >> 1; }
            else if (pn < 21) { dst = QI; ld = 1024; dcol = (pn - 17) * 256 + c0; const int j0 = c0 & 63; kind = j0 < 16 ? 2 : 0; pb = j0 >> 1; }
            else { if (c0 < 64) { dst = KI; ld = 64; dcol = c0; kind = c0 < 16 ? 2 : 0; pb = c0 >> 1; } else if (c0 < 80) { f32out = true; dcol = c0 - 64; } else skip = true; }
            if (skip) continue;
#pragma unroll
            for (int ai = 0; ai < 2; ++ai)
#pragma unroll
                for (int m = 0; m < 4; ++m) { const int row = row0 + ai * HALF + m * 16;
                    f32x4 v0 = acc[ai][bj][m][0], v1 = acc[ai][bj][m][1];
                    if (kind) { const float* cs = (kind == 1 ? csq + (size_t)row * 64 : csi + (size_t)row * 16) + pb * 2;
                        const f32x4 c01 = *(const f32x4*)cs, c23 = *(const f32x4*)(cs + 4);
                        f32x4 r0, r1;
                        r0[0] = v0[0] * c01[0] - v0[1] * c01[1]; r0[1] = v0[1] * c01[0] + v0[0] * c01[1];
                        r0[2] = v0[2] * c01[2] - v0[3] * c01[3]; r0[3] = v0[3] * c01[2] + v0[2] * c01[3];
                        r1[0] = v1[0] * c23[0] - v1[1] * c23[1]; r1[1] = v1[1] * c23[0] + v1[0] * c23[1];
                        r1[2] = v1[2] * c23[2] - v1[3] * c23[3]; r1[3] = v1[3] * c23[2] + v1[2] * c23[3];
                        v0 = r0; v1 = r1; }
                    if (f32out) { float* o = WI + (size_t)row * 16 + dcol; *(f32x4*)o = v0 * wscale; *(f32x4*)(o + 4) = v1 * wscale; }
                    else { u32x4 w; w.x = cvt_pk_bf16(v0[0], v0[1]); w.y = cvt_pk_bf16(v0[2], v0[3]); w.z = cvt_pk_bf16(v1[0], v1[1]); w.w = cvt_pk_bf16(v1[2], v1[3]);
                        *(u32x4*)(dst + (size_t)row * ld + dcol) = w; }
                    asm volatile("" ::: "memory"); }
        }
    }
};
__device__ __forceinline__ float gelu_t(float x) { const float u = 0.7978845608028654f * (x + 0.044715f * x * x * x); return x / (1.f + __expf(-2.f * u)); }
__device__ __forceinline__ float dppf(float old, float src, int ctrl_sel) {
    const int o = __float_as_int(old), s = __float_as_int(src);
    return __int_as_float(ctrl_sel == 0 ? __builtin_amdgcn_update_dpp(o, s, 0x111, 0xF, 0xF, false) : ctrl_sel == 1 ? __builtin_amdgcn_update_dpp(o, s, 0x112, 0xF, 0xF, false)
                        : ctrl_sel == 2 ? __builtin_amdgcn_update_dpp(o, s, 0x121, 0xF, 0xF, false) : __builtin_amdgcn_update_dpp(o, s, 0x122, 0xF, 0xF, false)); }
struct EpiConvGate {
    static constexpr bool PERM = true, AFTER_DRAIN = false;
    bf16_t* H; int ldh; const float* cw; const float* cb; int nff; PG8_LAS float* halo; int Mrows, seqmask;
    __device__ __forceinline__ void operator()(const f32x4 (&acc)[2][2][4][2], const Unit& u, int wr, int wc, int fr, int fq) const {
        const int cl = wc * 32 + 8 * fq, ch = u.pn * 128 + cl;
        if (fr >= 14) {
#pragma unroll
            for (int ai = 0; ai < 2; ++ai) { PG8_LAS float* hp = halo + ((ai * 2 + wr) * 2 + (fr - 14)) * 128 + cl; *(PG8_LAS f32x4*)hp = acc[ai][0][3][0]; *(PG8_LAS f32x4*)(hp + 4) = acc[ai][0][3][1]; } }
        asm volatile("s_waitcnt lgkmcnt(0)" ::: "memory"); __builtin_amdgcn_s_barrier(); asm volatile("" ::: "memory");
        f32x4 w0[2], w1[2], w2[2], bb[2];
#pragma unroll
        for (int n = 0; n < 2; ++n) { w0[n] = *(const f32x4*)(cw + ch + 4 * n); w1[n] = *(const f32x4*)(cw + nff + ch + 4 * n); w2[n] = *(const f32x4*)(cw + 2 * nff + ch + 4 * n); bb[n] = *(const f32x4*)(cb + ch + 4 * n); }
#pragma unroll
        for (int ai = 0; ai < 2; ++ai) {
            f32x4 h1[2], h2[2];
#pragma unroll
            for (int n = 0; n < 2; ++n) { h1[n] = (f32x4){0.f, 0.f, 0.f, 0.f}; h2[n] = h1[n]; }
            if (wr == 1 || ai == 1) { const int src = (wr == 1) ? ai * 2 : 1; const PG8_LAS float* hp = halo + (src * 2) * 128 + cl;
#pragma unroll
                for (int n = 0; n < 2; ++n) { h2[n] = *(const PG8_LAS f32x4*)(hp + 4 * n); h1[n] = *(const PG8_LAS f32x4*)(hp + 128 + 4 * n); } }
#pragma unroll
            for (int m = 0; m < 4; ++m) {
                const int lr = ai * HALF + wr * 64 + m * 16 + fr, row = u.pm * 254 + lr, t = row & seqmask;
                unsigned ow[4];
#pragma unroll
                for (int n = 0; n < 2; ++n) { float r[4];
#pragma unroll
                    for (int e = 0; e < 4; ++e) {
                        const float g = acc[ai][0][m][n][e];
                        float o1, o2;
                        if (m > 0) { const float gp = acc[ai][0][m > 0 ? m - 1 : 0][n][e]; o1 = dppf(gp, gp, 2); o2 = dppf(gp, gp, 3); }
                        else { o1 = h1[n][e]; o2 = (fr == 0) ? h2[n][e] : h1[n][e]; }
                        float p1 = dppf(o1, g, 0), p2 = dppf(o2, g, 1);
                        p1 = (t == 0) ? 0.f : p1; p2 = (t <= 1) ? 0.f : p2;
                        const float cv = bb[n][e] + w0[n][e] * p2 + w1[n][e] * p1 + w2[n][e] * g;
                        r[e] = gelu_t(cv) * acc[ai][1][m][n][e]; }
                    ow[2 * n] = cvt_pk_bf16(r[0], r[1]); ow[2 * n + 1] = cvt_pk_bf16(r[2], r[3]); }
                if ((u.pm == 0 || lr >= 2) && row < Mrows) *(u32x4*)(H + (size_t)row * ldh + ch) = (u32x4){ow[0], ow[1], ow[2], ow[3]};
            }
        }
    }
};
}
constexpr int NWAVES = 8;
constexpr int BATCH = 2, SEQ = 8192, DM = 1024, M = BATCH * SEQ;
constexpr int FF = 2816, FF2 = 2 * FF, NQKV0 = 3072, N1PAD = 5632, W_IN_AB = 3080, W_IN_C = 5456;
constexpr float LN_EPS = 1e-5f, ALPHA = 1.4142135623730951f;
constexpr float IDX_SCALE = 0.03125f, DSA_SCALE = 0.0625f;
constexpr int NIN = 24;
constexpr size_t MiB = 1u << 20;
constexpr size_t WS_CTL = 0, CTL_ZERO_BYTES = 64 * 1024;
constexpr size_t WS_LSF = 1 * MiB, WS_CUM = WS_LSF + 512 * 1024;
constexpr size_t WS_XB = 2 * MiB;
constexpr size_t WS_W0IN = 34 * MiB, WS_W0O = 40 * MiB, WS_W0UP = 42 * MiB, WS_W0DN = 53 * MiB;
constexpr size_t WS_W1IN = 34 * MiB, WS_WC = 45 * MiB, WS_CSQ = 51 * MiB, WS_CSI = 55 * MiB, WS_WI = 56 * MiB, WS_KI = 57 * MiB;
constexpr size_t WS_BIG = 59 * MiB;
constexpr size_t WS_QO = WS_BIG, WS_K = WS_QO + 32 * MiB, WS_V = WS_K + 32 * MiB;
constexpr size_t WS_H = WS_BIG;
constexpr size_t WS_QD = WS_BIG, WS_QI = WS_QD + 128 * MiB, WS_KL = WS_QI + 32 * MiB, WS_IDX = WS_KL + 8 * MiB;
constexpr size_t WS_W1UP = 235 * MiB, WS_W1DN = 246 * MiB, WS_END = 256 * MiB;
static_assert(WS_H + (size_t)M * FF2 * 2 <= WS_W1UP && WS_IDX + (size_t)M * 256 * 2 <= WS_W1UP && WS_W1DN + (size_t)DM * FF * 2 <= WS_END && WS_W0DN + (size_t)DM * FF * 2 <= WS_BIG && WS_KI + (size_t)M * 64 * 2 <= WS_BIG, "d_ws map");
constexpr int CW_TMO = 0, CW_CODE = 1, CW_KN = 64, CW_BAR = 4096;
constexpr int RING_OFF = 0, RING_BYTES = 145408;
constexpr int HALO_OFF = 131072;
constexpr int LDSCTL_OFF = RING_BYTES, MISC_OFF = LDSCTL_OFF + 320;
constexpr int LDS_BYTES = 147456;
#define GAS __attribute__((address_space(1)))
#define LAS __attribute__((address_space(3)))
typedef unsigned short bf16;
typedef unsigned v4u __attribute__((ext_vector_type(4)));
typedef float f32x4 __attribute__((ext_vector_type(4)));
typedef short bf16x8 __attribute__((ext_vector_type(8)));
typedef GAS unsigned gu32;
typedef GAS unsigned long long gu64;
#define RLX_AGENT __ATOMIC_RELAXED, __HIP_MEMORY_SCOPE_AGENT
#define LDS_WAIT() asm volatile("s_waitcnt lgkmcnt(0)" ::: "memory")
#define VM_WAIT() asm volatile("s_waitcnt vmcnt(0)" ::: "memory")
__device__ __forceinline__ unsigned long long rt() { return __builtin_amdgcn_s_memrealtime(); }
__device__ __forceinline__ unsigned f2bf(float f) { unsigned u = __builtin_bit_cast(unsigned, f); return (u + 0x7fffu + ((u >> 16) & 1u)) >> 16; }
__device__ __forceinline__ unsigned pk2(float lo, float hi) { return f2bf(lo) | (f2bf(hi) << 16); }

#define XB_TMO      128
#define XB_XCNT(j)  (256  + 64 * (j))
#define XB_XSUB(j)  (1280 + 64 * (j))
#define XB_XGEN(j)  (2304 + 64 * (j))
#define XB_TOP      3328
#define XB_TOPGEN   3392
#define XCD_BAR_WORDS 3456
#define XB_SPIN_CAP (1u << 18)

__device__ __forceinline__ unsigned xb_ld(unsigned* p)              { return __hip_atomic_load(p, __ATOMIC_RELAXED, __HIP_MEMORY_SCOPE_AGENT); }
__device__ __forceinline__ unsigned xb_add(unsigned* p, unsigned v) { return __hip_atomic_fetch_add(p, v, __ATOMIC_RELAXED, __HIP_MEMORY_SCOPE_AGENT); }
__device__ __forceinline__ unsigned xb_xcc_id() { return (unsigned)__builtin_amdgcn_s_getreg((3 << 11) | 20) & 0xFu; }
#define XB_SPIN(cond, bar) do { unsigned _sp = 0; while (cond) { __builtin_amdgcn_s_sleep(1); \
    if ((++_sp & 255u) == 0u) { if (xb_ld(&(bar)[XB_TMO])) break; if (_sp > XB_SPIN_CAP) { atomicAdd(&(bar)[XB_TMO], 1u); break; } } } } while (0)

struct XcdBarrier {
    unsigned* bar; unsigned x;
    volatile LAS unsigned* st;
};

__device__ __forceinline__ XcdBarrier xcd_barrier_post(unsigned* bar, volatile LAS unsigned* st) {
    XcdBarrier b; b.bar = bar; b.x = xb_xcc_id(); b.st = st;
    if (threadIdx.x == 0) (void)xb_add(&bar[XB_XCNT(b.x)], 1u);
    return b;
}
__device__ __forceinline__ void xcd_barrier_complete(unsigned* bar, unsigned x, unsigned& nloc, unsigned& nx) {
    const unsigned G = gridDim.x * gridDim.y * gridDim.z;
    unsigned sum, cnt, mine, sp = 0u;
    for (;;) {
        sum = 0u; cnt = 0u; mine = 0u;
#pragma unroll
        for (unsigned j = 0; j < 16; ++j) { const unsigned c = xb_ld(&bar[XB_XCNT(j)]); sum += c; cnt += (c > 0u) ? 1u : 0u; mine = (j == x) ? c : mine; }
        if (sum == G) break;
        __builtin_amdgcn_s_sleep(1);
        if ((++sp & 255u) == 0u) { if (xb_ld(&bar[XB_TMO])) break; if (sp > XB_SPIN_CAP) { atomicAdd(&bar[XB_TMO], 1u); break; } }
    }
    nloc = mine > 0u ? mine : 1u; nx = cnt > 0u ? cnt : 1u;
}

__device__ __forceinline__ void xcd_barrier(const XcdBarrier& b) {
    asm volatile("s_waitcnt vmcnt(0)" ::: "memory");
    __syncthreads();
    if (threadIdx.x == 0) {
        unsigned* bar = b.bar;
        __builtin_amdgcn_s_waitcnt(0);
        unsigned nloc = b.st[0], nx = b.st[1];
        if (nloc == 0u) { xcd_barrier_complete(bar, b.x, nloc, nx); b.st[0] = nloc; b.st[1] = nx; }
        const unsigned old = xb_add(&bar[XB_XSUB(b.x)], 1u);
        const unsigned gen = old / nloc;
        if (old + 1u == (gen + 1u) * nloc) {
            __builtin_amdgcn_fence(__ATOMIC_RELEASE, "agent");
            asm volatile("s_waitcnt vmcnt(0)" ::: "memory");
            const unsigned og = xb_add(&bar[XB_TOP], 1u);
            const unsigned tg = og / nx;
            if (og + 1u == (tg + 1u) * nx) xb_add(&bar[XB_TOPGEN], 1u);
            else XB_SPIN(xb_ld(&bar[XB_TOPGEN]) == tg, bar);
            __builtin_amdgcn_fence(__ATOMIC_ACQUIRE, "agent");
            xb_add(&bar[XB_XGEN(b.x)], 1u);
            asm volatile("s_waitcnt vmcnt(0)" ::: "memory");
        } else {
            XB_SPIN(xb_ld(&bar[XB_XGEN(b.x)]) == gen, bar);
            __builtin_amdgcn_fence(__ATOMIC_ACQUIRE, "agent");
            asm volatile("s_waitcnt vmcnt(0)" ::: "memory");
        }
    }
    __syncthreads();
}

typedef float f32x16 __attribute__((ext_vector_type(16)));
typedef unsigned v2u __attribute__((ext_vector_type(2)));
typedef short s16x4 __attribute__((ext_vector_type(4)));
typedef unsigned short u16;
struct Args { const float* in[NIN]; float* out; unsigned char* ws; };
struct Frame {
    LAS unsigned char* lds; volatile LAS unsigned* MISC; gu32* ctl;
    int tid, lane, wave, G, vcu;
    unsigned char* ws; float* out;
};
__device__ __forceinline__ float wave_sum(float v) {
#pragma unroll
    for (int o = 1; o < 64; o <<= 1) v += __shfl_xor(v, o);
    return v;
}
__device__ __forceinline__ const float* argp(int k) { const __attribute__((address_space(4))) char* p = (const __attribute__((address_space(4))) char*)__builtin_amdgcn_kernarg_segment_ptr(); asm volatile("" : "+s"(p)); return *(const float* const __attribute__((address_space(4)))*)(p + 8 * k); }
__device__ __forceinline__ int opaque(int v) { asm volatile("" : "+v"(v)); return v; }
__device__ __forceinline__ float bf2f(unsigned short b) { return __uint_as_float((unsigned)b << 16); }
__device__ __forceinline__ float bflo(unsigned w) { return __uint_as_float(w << 16); }
__device__ __forceinline__ float bfhi(unsigned w) { return __uint_as_float(w & 0xffff0000u); }
__device__ __forceinline__ unsigned cvtpk(float lo, float hi) { unsigned r; asm volatile("v_cvt_pk_bf16_f32 %0, %1, %2" : "=v"(r) : "v"(lo), "v"(hi)); return r; }

constexpr int TR_ROWB = 144;
template <int ROT> __device__ __forceinline__ int tr_dst(int j) { if (ROT == 0 || j >= ROT) return j; return 2 * (j & (ROT / 2 - 1)) + (j / (ROT / 2)); }
struct TrItem { const float* W; int Nsrc, K, sbase, nvalid, k0; bf16* WT; int n0; };
__device__ __forceinline__ void tr_load(const TrItem& it, f32x4 (&v)[16], int lane) {
    const int nl = lane & 15, kq = lane >> 4; const bool ok = 4 * nl < it.nvalid;
    const float* src = it.W + (size_t)(it.k0 + 16 * kq) * it.Nsrc + it.sbase + 4 * nl;
#pragma unroll
    for (int i = 0; i < 16; ++i) v[i] = ok ? *(const GAS f32x4*)(src + (size_t)i * it.Nsrc) : (f32x4){0.f, 0.f, 0.f, 0.f};
}
template <int ROT> __device__ __forceinline__ void tr_store(const TrItem& it, const f32x4 (&v)[16], LAS unsigned char* scr, int lane) {
    const int nl = lane & 15, kq = lane >> 4;
#pragma unroll
    for (int e = 0; e < 4; ++e) { const int n = tr_dst<ROT>(4 * nl + e);
        v4u w0, w1;
        w0.x = pk2(v[0][e], v[1][e]); w0.y = pk2(v[2][e], v[3][e]); w0.z = pk2(v[4][e], v[5][e]); w0.w = pk2(v[6][e], v[7][e]);
        w1.x = pk2(v[8][e], v[9][e]); w1.y = pk2(v[10][e], v[11][e]); w1.z = pk2(v[12][e], v[13][e]); w1.w = pk2(v[14][e], v[15][e]);
        *(LAS v4u*)(scr + n * TR_ROWB + kq * 32) = w0; *(LAS v4u*)(scr + n * TR_ROWB + kq * 32 + 16) = w1; }
    LDS_WAIT(); asm volatile("" ::: "memory");
    const int c = lane & 7, r8 = lane >> 3;
#pragma unroll
    for (int j = 0; j < 8; ++j) { const int n = 8 * j + r8; const v4u o = *(const LAS v4u*)(scr + n * TR_ROWB + c * 16);
        *(GAS v4u*)(it.WT + (size_t)(it.n0 + n) * it.K + it.k0 + 8 * c) = o; }
    LDS_WAIT(); asm volatile("" ::: "memory");
}
__device__ __forceinline__ TrItem tr_plain(const float* W, int K, int N, bf16* WT, int item) { const int nt = N / 64, kb = item / nt, t = item % nt; return TrItem{W, N, K, 64 * t, 64, 64 * kb, WT, 64 * t}; }
__device__ __forceinline__ TrItem tr_up(const float* W, bf16* WT, int item) { const int nt = FF2 / 64, kb = item / nt, t = item % nt, pn = t >> 2, q = t & 3;
    return TrItem{W, FF2, DM, (q < 2 ? 0 : FF) + 128 * pn + 64 * (q & 1), 64, 64 * kb, WT, 64 * t}; }
__device__ __forceinline__ TrItem tr_l0in(const float* W, bf16* WT, int item) { const int nt = NQKV0 / 64, kb = item / nt, t = item % nt, blk = t >> 3, sb = (blk & 1) * 3 + (blk >> 1);
    return TrItem{W, W_IN_AB, DM, sb * 512 + (t & 7) * 64, 64, 64 * kb, WT, 64 * t}; }
__device__ __forceinline__ TrItem tr_l1in(const float* W, bf16* WT, int item, int& rot) { const int nt = N1PAD / 64, kb = item / nt, t = item % nt;
    int nvalid = 64; rot = 0;
    if (t < 68) rot = (t & 3) == 0 ? 64 : 0; else if (t < 85) rot = 16; else if (t == 85) nvalid = 16; else nvalid = 0;
    return TrItem{W, W_IN_C, DM, 64 * t, nvalid, 64 * kb, WT, 64 * t}; }
__device__ __forceinline__ void p0_row(const f32x4 (&v)[4], bf16* orow, float* lsf, const LAS float* wf, const float* bfv, int lane) {
    GAS unsigned long long* o8 = (GAS unsigned long long*)orow + lane;
#pragma unroll
    for (int j = 0; j < 4; ++j) o8[64 * j] = (unsigned long long)pk2(v[j].x, v[j].y) | ((unsigned long long)pk2(v[j].z, v[j].w) << 32);
    float a[8] = {0.f, 0.f, 0.f, 0.f, 0.f, 0.f, 0.f, 0.f};
#pragma unroll
    for (int j = 0; j < 4; ++j)
#pragma unroll
        for (int e = 0; e < 4; ++e) { const int k = 256 * j + 4 * lane + e; const f32x4 w0 = *(const LAS f32x4*)(wf + k * 8), w1 = *(const LAS f32x4*)(wf + k * 8 + 4); const float xv = v[j][e];
            a[0] += xv * w0[0]; a[1] += xv * w0[1]; a[2] += xv * w0[2]; a[3] += xv * w0[3]; a[4] += xv * w1[0]; a[5] += xv * w1[1]; a[6] += xv * w1[2]; a[7] += xv * w1[3]; }
    const bool b0 = lane & 1, b1 = lane & 2, b2 = lane & 4;
    float c[4], d[2];
#pragma unroll
    for (int i = 0; i < 4; ++i) { const float snd = b0 ? a[i] : a[4 + i], keep = b0 ? a[4 + i] : a[i]; c[i] = keep + __shfl_xor(snd, 1); }
#pragma unroll
    for (int i = 0; i < 2; ++i) { const float snd = b1 ? c[i] : c[2 + i], keep = b1 ? c[2 + i] : c[i]; d[i] = keep + __shfl_xor(snd, 2); }
    float e1; { const float snd = b2 ? d[0] : d[1], keep = b2 ? d[1] : d[0]; e1 = keep + __shfl_xor(snd, 4); }
    e1 += __shfl_xor(e1, 8); e1 += __shfl_xor(e1, 16); e1 += __shfl_xor(e1, 32);
    if (lane < 8) { const int h = 4 * (lane & 1) + 2 * ((lane >> 1) & 1) + ((lane >> 2) & 1); const float f = e1 + bfv[h]; lsf[h] = -(fmaxf(-f, 0.f) + log1pf(__expf(-fabsf(f)))); }
}
__device__ __forceinline__ void p0_prologue(Frame& F) {
    const int tid_ = opaque(F.tid), lane_ = tid_ & 63;
    LAS float* wf = (LAS float*)(F.lds + RING_OFF + 73728);
    const float* w0in = argp(2);
    for (int i = tid_; i < 1024 * 8; i += NWAVES * 64) wf[i] = w0in[(size_t)(i >> 3) * W_IN_AB + 3072 + (i & 7)];
    __syncthreads();
    const int gw = F.vcu * NWAVES + F.wave, NGW = F.G * NWAVES;
    constexpr int I_IN = 16 * (NQKV0 / 64), I_O = 16 * 16, I_UP = 16 * (FF2 / 64), I_DN = (FF / 64) * 16;
    constexpr int NITEMS = I_IN + I_O + 2 * I_UP + 2 * I_DN;
    LAS unsigned char* scrb = F.lds + RING_OFF + F.wave * 9216;
    for (int it = gw; it < NITEMS; it += NGW) {
        int r = it; TrItem ti;
        if (r < I_IN) ti = tr_l0in(argp(2), (bf16*)(F.ws + WS_W0IN), r);
        else if ((r -= I_IN) < I_O) ti = tr_plain(argp(4), DM, DM, (bf16*)(F.ws + WS_W0O), r);
        else if ((r -= I_O) < I_UP) ti = tr_up(argp(7), (bf16*)(F.ws + WS_W0UP), r);
        else if ((r -= I_UP) < I_DN) ti = tr_plain(argp(10), FF, DM, (bf16*)(F.ws + WS_W0DN), r);
        else if ((r -= I_DN) < I_UP) ti = tr_up(argp(18), (bf16*)(F.ws + WS_W1UP), r);
        else { r -= I_UP; ti = tr_plain(argp(21), FF, DM, (bf16*)(F.ws + WS_W1DN), r); }
        f32x4 v[16]; tr_load(ti, v, lane_); tr_store<0>(ti, v, scrb, lane_);
    }
    const float* x = argp(0); bf16* XB = (bf16*)(F.ws + WS_XB); float* LSF = (float*)(F.ws + WS_LSF);
    const float* bfv = argp(3);
    f32x4 vn[4];
    if (gw < M) {
#pragma unroll
        for (int j = 0; j < 4; ++j) vn[j] = ((const GAS f32x4*)(x + (size_t)gw * DM) + lane_)[64 * j]; }
    for (int m = gw; m < M; m += NGW) {
        f32x4 vc[4];
#pragma unroll
        for (int j = 0; j < 4; ++j) vc[j] = vn[j];
        if (m + NGW < M) {
#pragma unroll
            for (int j = 0; j < 4; ++j) vn[j] = ((const GAS f32x4*)(x + (size_t)(m + NGW) * DM) + lane_)[64 * j]; }
        p0_row(vc, XB + (size_t)m * DM, LSF + (size_t)m * 8, wf, bfv, lane_);
    }
}

__device__ __forceinline__ void p1b_scan_kn(Frame& F) {
    const int tid_ = opaque(F.tid), lane_ = tid_ & 63;
    const float* LSF = (const float*)(F.ws + WS_LSF); float* CUM = (float*)(F.ws + WS_CUM);
    if (blockIdx.x < 16) {
        const int b = blockIdx.x >> 3, h = blockIdx.x & 7, t0 = 16 * tid_;
        float v[16]; float s = 0.f;
#pragma unroll
        for (int j = 0; j < 16; ++j) { s += LSF[(size_t)(b * SEQ + t0 + j) * 8 + h]; v[j] = s; }
        float inc = s;
#pragma unroll
        for (int o = 1; o < 64; o <<= 1) { const float u = __shfl_up(inc, o); if (lane_ >= o) inc += u; }
        LAS float* wt = (LAS float*)(F.lds + RING_OFF);
        if (lane_ == 63) wt[F.wave] = inc;
        __syncthreads();
        float off = inc - s;
        for (int w = 0; w < F.wave; ++w) off += wt[w];
#pragma unroll
        for (int j = 0; j < 16; ++j) CUM[(size_t)(b * 8 + h) * SEQ + t0 + j] = off + v[j];
        __syncthreads();
    } else {
        const bf16* KB = (const bf16*)(F.ws + WS_K);
        const int gw = (blockIdx.x - 16) * NWAVES + F.wave, NGW = (F.G - 16) * NWAVES;
        float mx0 = 0.f, mx1 = 0.f;
        for (int m = gw; m < M; m += NGW) {
            const v4u w = *(const GAS v4u*)(KB + (size_t)m * DM + 512 + lane_ * 8);
            float s = bflo(w.x) * bflo(w.x) + bfhi(w.x) * bfhi(w.x) + bflo(w.y) * bflo(w.y) + bfhi(w.y) * bfhi(w.y) + bflo(w.z) * bflo(w.z) + bfhi(w.z) * bfhi(w.z) + bflo(w.w) * bflo(w.w) + bfhi(w.w) * bfhi(w.w);
            s += __shfl_xor(s, 1); s += __shfl_xor(s, 2); s += __shfl_xor(s, 4);
            if (m < SEQ) mx0 = fmaxf(mx0, s); else mx1 = fmaxf(mx1, s);
        }
        if ((lane_ & 7) == 0) { atomicMax((unsigned*)(F.ctl + CW_KN) + (lane_ >> 3), __float_as_uint(mx0)); atomicMax((unsigned*)(F.ctl + CW_KN) + 8 + (lane_ >> 3), __float_as_uint(mx1)); }
    }
}
__device__ __forceinline__ void ln_phase(Frame& F, float* y, const float* g, const float* bta, bf16* xb) {
    const int tid_ = opaque(F.tid), lane_ = tid_ & 63;
    const int gw = F.vcu * NWAVES + F.wave, NGW = F.G * NWAVES;
    f32x4 gv[4], bv[4];
#pragma unroll
    for (int j = 0; j < 4; ++j) { gv[j] = ((const GAS f32x4*)g)[lane_ + 64 * j]; bv[j] = ((const GAS f32x4*)bta)[lane_ + 64 * j]; }
    for (int m = gw; m < M; m += NGW) {
        GAS f32x4* yr = (GAS f32x4*)(y + (size_t)m * DM) + lane_;
        f32x4 v[4]; float s = 0.f;
#pragma unroll
        for (int j = 0; j < 4; ++j) { v[j] = yr[64 * j]; s += (v[j].x + v[j].y) + (v[j].z + v[j].w); }
        const float mean = wave_sum(s) * (1.f / DM); float s2 = 0.f;
#pragma unroll
        for (int j = 0; j < 4; ++j) { v[j] = v[j] - mean; s2 += (v[j].x * v[j].x + v[j].y * v[j].y) + (v[j].z * v[j].z + v[j].w * v[j].w); }
        const float rstd = 1.f / sqrtf(wave_sum(s2) * (1.f / DM) + LN_EPS);
#pragma unroll
        for (int j = 0; j < 4; ++j) { v[j] = v[j] * rstd * gv[j] + bv[j]; yr[64 * j] = v[j]; }
        if (xb) { GAS unsigned long long* o8 = (GAS unsigned long long*)(xb + (size_t)m * DM) + lane_;
#pragma unroll
            for (int j = 0; j < 4; ++j) o8[64 * j] = (unsigned long long)pk2(v[j].x, v[j].y) | ((unsigned long long)pk2(v[j].z, v[j].w) << 32); }
    }
}
__device__ __forceinline__ float gelu_tanh(float x) { const float u = 0.7978845608028654f * (x + 0.044715f * x * x * x); return x / (1.f + __expf(-2.f * u)); }
__device__ __forceinline__ void conv_phase(Frame& F, bf16* H, const float* cw, const float* cb) {
    const int tid_ = opaque(F.tid), lane_ = tid_ & 63; (void)lane_;
    constexpr int NCG = FF / 8, NRUN = M / 16;
    const int gt = F.vcu * (NWAVES * 64) + tid_, NGT = F.G * NWAVES * 64;
    for (int it = gt; it < NCG * NRUN; it += NGT) {
        const int cg = it % NCG, run = it / NCG, c0 = cg * 8, row0 = run * 16;
        float w0[8], w1[8], w2[8], b0[8];
#pragma unroll
        for (int e = 0; e < 8; ++e) { w0[e] = cw[c0 + e]; w1[e] = cw[FF + c0 + e]; w2[e] = cw[2 * FF + c0 + e]; b0[e] = cb[c0 + e]; }
        v4u g2 = (v4u){0u, 0u, 0u, 0u}, g1 = g2;
        if ((row0 & (SEQ - 1)) != 0) { g2 = *(const GAS v4u*)(H + (size_t)(row0 - 2) * FF2 + c0); g1 = *(const GAS v4u*)(H + (size_t)(row0 - 1) * FF2 + c0); }
#pragma unroll 1
        for (int jb = 0; jb < 16; jb += 4) {
            v4u gq[4], uq[4];
#pragma unroll
            for (int j = 0; j < 4; ++j) { const size_t off = (size_t)(row0 + jb + j) * FF2 + c0; gq[j] = *(const GAS v4u*)(H + off); uq[j] = *(const GAS v4u*)(H + off + FF); }
#pragma unroll
            for (int j = 0; j < 4; ++j) {
                const size_t off = (size_t)(row0 + jb + j) * FF2 + c0;
                const v4u g0 = gq[j], uu = uq[j];
                unsigned gg2[4] = {g2.x, g2.y, g2.z, g2.w}, gg1[4] = {g1.x, g1.y, g1.z, g1.w}, gg0[4] = {g0.x, g0.y, g0.z, g0.w}, u4[4] = {uu.x, uu.y, uu.z, uu.w}, o[4];
#pragma unroll
                for (int p = 0; p < 4; ++p) {
                    const float ca = b0[2 * p] + w0[2 * p] * bflo(gg2[p]) + w1[2 * p] * bflo(gg1[p]) + w2[2 * p] * bflo(gg0[p]);
                    const float cb2 = b0[2 * p + 1] + w0[2 * p + 1] * bfhi(gg2[p]) + w1[2 * p + 1] * bfhi(gg1[p]) + w2[2 * p + 1] * bfhi(gg0[p]);
                    o[p] = pk2(gelu_tanh(ca) * bflo(u4[p]), gelu_tanh(cb2) * bfhi(u4[p]));
                }
                *(GAS v4u*)(H + off + FF) = (v4u){o[0], o[1], o[2], o[3]};
                g2 = g1; g1 = g0;
            }
        }
    }
}
__device__ __forceinline__ void p8_prep(Frame& F) {
    const int tid_ = opaque(F.tid), lane_ = tid_ & 63;
    LAS unsigned char* scrb = F.lds + RING_OFF + F.wave * 9216;
    const int gw = F.vcu * NWAVES + F.wave, NGW = F.G * NWAVES;
    constexpr int I_IN1 = 16 * (N1PAD / 64);
    for (int it = gw; it < I_IN1; it += NGW) { int rot; const TrItem ti = tr_l1in(argp(13), (bf16*)(F.ws + WS_W1IN), it, rot);
        f32x4 v[16]; tr_load(ti, v, lane_);
        if (rot == 64) tr_store<64>(ti, v, scrb, lane_); else if (rot == 16) tr_store<16>(ti, v, scrb, lane_); else tr_store<0>(ti, v, scrb, lane_); }
    const int gt = F.vcu * (NWAVES * 64) + tid_, NGT = F.G * NWAVES * 64;
    const float* wuv = argp(14); const float* wo = argp(15); bf16* WcT = (bf16*)(F.ws + WS_WC);
    for (int it = gt; it < 1024 * 384; it += NGT) {
        const int n = it & 1023, hcg = it >> 10, h = hcg / 24, c0 = (hcg % 24) * 8;
        float a[8] = {0.f, 0.f, 0.f, 0.f, 0.f, 0.f, 0.f, 0.f};
        for (int d = 0; d < 64; ++d) { const float w = wo[(size_t)(h * 64 + d) * DM + n];
#pragma unroll
            for (int e = 0; e < 8; ++e) a[e] += wuv[(size_t)(h * 192 + c0 + e) * 64 + d] * w; }
        *(GAS v4u*)(WcT + (size_t)n * 3072 + h * 192 + c0) = (v4u){pk2(a[0], a[1]), pk2(a[2], a[3]), pk2(a[4], a[5]), pk2(a[6], a[7])};
    }
    const int* pos = (const int*)argp(1); float* csq = (float*)(F.ws + WS_CSQ); float* csi = (float*)(F.ws + WS_CSI);
    for (int it = gt; it < M * 40; it += NGT) {
        const int row = it / 40, i = it % 40;
        double fq = 1.0; { const double rr = i < 32 ? 0.6636012376960885 : 0.19392274474868576; const int ii = i < 32 ? i : i - 32; for (int q = 0; q < ii; ++q) fq *= rr; }
        const float ang = (float)pos[row] * (float)fq;
        double rev = (double)ang * 0.15915494309189535; rev -= __builtin_rint(rev);
        const float fr = (float)rev, c = __builtin_amdgcn_cosf(fr), s = __builtin_amdgcn_sinf(fr);
        float* dst = i < 32 ? csq + (size_t)row * 64 + 2 * i : csi + (size_t)row * 16 + 2 * (i - 32);
        dst[0] = c; dst[1] = s;
    }
}
constexpr int A0_K = 0, A0_V = 16384, A0_CK = 32768, A0_FLAG = 33280, A0_WS = 33344;
__device__ __forceinline__ int crow(int r, int hi) { return (r & 3) + 8 * (r >> 2) + 4 * hi; }
__device__ __forceinline__ s16x4 vtr(const LAS unsigned char* p) { return __builtin_bit_cast(s16x4, __builtin_amdgcn_ds_read_tr16_b64_v4i16((LAS s16x4*)p)); }
__device__ __forceinline__ void sb_sub(f32x16& p, int kbase, int tq, int hi, bool needmask, float& R) {
    float ls[16];
#pragma unroll
    for (int r = 0; r < 16; ++r) { const float z = p[r], e = __expf(-fabsf(z)), sp = fmaxf(z, 0.f) + __logf(1.f + e); const bool vis = !needmask || (kbase + crow(r, hi) < tq);
        ls[r] = vis ? -sp : 0.f; p[r] = vis ? (z - sp) : -INFINITY; }
    float T[4], Tp[4];
#pragma unroll
    for (int g = 0; g < 4; ++g) { T[g] = (ls[4 * g] + ls[4 * g + 1]) + (ls[4 * g + 2] + ls[4 * g + 3]); Tp[g] = __shfl_xor(T[g], 32); }
    float E = 0.f;
#pragma unroll
    for (int g = 3; g >= 0; --g) {
        const float a3 = R + E + (hi == 0 ? Tp[g] : 0.f), a2 = a3 + ls[4 * g + 3], a1 = a2 + ls[4 * g + 2], a0 = a1 + ls[4 * g + 1];
        p[4 * g + 3] = __expf(p[4 * g + 3] + a3); p[4 * g + 2] = __expf(p[4 * g + 2] + a2); p[4 * g + 1] = __expf(p[4 * g + 1] + a1); p[4 * g] = __expf(p[4 * g] + a0);
        E += T[g] + Tp[g];
    }
    R += E;
}
template <bool FOX> __device__ __forceinline__ void attn0_unit(Frame& F, int b, int h, int qb) {
    LAS unsigned char* L = F.lds + RING_OFF;
    const int tid = opaque(F.tid), lane = tid & 63, wave = F.wave, r32 = lane & 31, hi = lane >> 5;
    const bf16* Qg = (const bf16*)(F.ws + WS_QO); const bf16* Kg = (const bf16*)(F.ws + WS_K); const bf16* Vg = (const bf16*)(F.ws + WS_V); bf16* Og = (bf16*)(F.ws + WS_XB);
    const float* CUM = (const float*)(F.ws + WS_CUM) + (size_t)(b * 8 + (h & 7)) * SEQ;
    const size_t rowbase = (size_t)b * SEQ; const int q0 = qb * 256, qmin = q0 + wave * 32, qmax = qmin + 31, tq = qmin + r32;
    bf16x8 qf[4];
#pragma unroll
    for (int ks = 0; ks < 4; ++ks) qf[ks] = *(const GAS bf16x8*)(Qg + (rowbase + tq) * DM + h * 64 + 16 * ks + 8 * hi);
    float cq = 0.f, qn = 0.f, knmax = 0.f;
    if (FOX) { cq = CUM[tq]; float s = 0.f;
#pragma unroll
        for (int ks = 0; ks < 4; ++ks)
#pragma unroll
            for (int j = 0; j < 8; ++j) { const float v = bf2f((unsigned short)qf[ks][j]); s += v * v; }
        s += __shfl_xor(s, 32); qn = sqrtf(s); knmax = sqrtf(__uint_as_float(__hip_atomic_load(F.ctl + CW_KN + b * 8 + (h & 7), RLX_AGENT))); }
    f32x16 o0, o1;
#pragma unroll
    for (int r = 0; r < 16; ++r) { o0[r] = 0.f; o1[r] = 0.f; }
    float mrun = -INFINITY, lrun = 0.f, R = 0.f; bool wdone = false;
    const int kt_hi = qb * 4 + 3;
    const int skey = tid >> 3, sch = tid & 7;
    const size_t goff = (rowbase + skey) * DM + h * 64 + sch * 8;
    const int kdst = A0_K + skey * 128 + ((sch ^ (skey & 7)) * 16);
    const int vdst = A0_V + skey * 128 + (((sch >> 2) ^ ((skey >> 1) & 1)) * 64) + (sch & 3) * 16;
    LAS float* wsf = (LAS float*)(L + A0_WS) + wave * 32;
    {   const v4u kreg = *(const GAS v4u*)(Kg + goff + (size_t)kt_hi * 64 * DM), vreg = *(const GAS v4u*)(Vg + goff + (size_t)kt_hi * 64 * DM);
        *(LAS v4u*)(L + kdst) = kreg; *(LAS v4u*)(L + vdst) = vreg;
        if (FOX && tid < 64) ((LAS float*)(L + A0_CK))[tid] = CUM[kt_hi * 64 + tid]; }
    __syncthreads();
    int buf = 0;
    for (int kt = kt_hi; ; --kt) {
        const bool more = kt > 0; const int k0 = kt * 64;
        v4u kreg = (v4u){0u, 0u, 0u, 0u}, vreg = kreg; float ckreg = 0.f;
        if (more) { kreg = *(const GAS v4u*)(Kg + goff + (size_t)(kt - 1) * 64 * DM); vreg = *(const GAS v4u*)(Vg + goff + (size_t)(kt - 1) * 64 * DM); if (FOX && tid < 64) ckreg = CUM[(kt - 1) * 64 + tid]; }
        const bool active = !wdone && (k0 <= qmax);
        if (active) {
            const bool needmask = (k0 + 63 >= qmin);
            const LAS unsigned char* Kb = L + A0_K + buf * 8192; const LAS unsigned char* Vb = L + A0_V + buf * 8192;
            f32x16 p0, p1;
#pragma unroll
            for (int r = 0; r < 16; ++r) { p0[r] = 0.f; p1[r] = 0.f; }
#pragma unroll
            for (int ks = 0; ks < 4; ++ks) { const int ch = ((2 * ks + hi) ^ (r32 & 7)) * 16;
                const bf16x8 a0 = *(const LAS bf16x8*)(Kb + r32 * 128 + ch), a1 = *(const LAS bf16x8*)(Kb + (32 + r32) * 128 + ch);
                p0 = __builtin_amdgcn_mfma_f32_32x32x16_bf16(a0, qf[ks], p0, 0, 0, 0); p1 = __builtin_amdgcn_mfma_f32_32x32x16_bf16(a1, qf[ks], p1, 0, 0, 0); }
            if (FOX) {
                const LAS float* ckb = (const LAS float*)(L + A0_CK) + buf * 64;
#pragma unroll
                for (int g = 0; g < 4; ++g) { const f32x4 c0v = *(const LAS f32x4*)(ckb + 8 * g + 4 * hi), c1v = *(const LAS f32x4*)(ckb + 32 + 8 * g + 4 * hi);
#pragma unroll
                    for (int i = 0; i < 4; ++i) { p0[4 * g + i] += cq - c0v[i]; p1[4 * g + i] += cq - c1v[i]; } }
                if (needmask) {
#pragma unroll
                    for (int r = 0; r < 16; ++r) { const int key = k0 + crow(r, hi); if (key > tq) p0[r] = -INFINITY; if (key + 32 > tq) p1[r] = -INFINITY; } }
                float rm = fmaxf(p0[0], p1[0]);
#pragma unroll
                for (int r = 1; r < 16; ++r) rm = fmaxf(rm, fmaxf(p0[r], p1[r]));
                rm = fmaxf(rm, __shfl_xor(rm, 32));
                const float mnew = fmaxf(mrun, rm), alpha = __expf(mrun - mnew);
                float ps = 0.f;
#pragma unroll
                for (int r = 0; r < 16; ++r) { p0[r] = __expf(p0[r] - mnew); p1[r] = __expf(p1[r] - mnew); ps += p0[r] + p1[r]; }
                lrun = lrun * alpha + ps; mrun = mnew;
                if (__any(alpha != 1.f)) {
                    if (hi == 0) wsf[r32] = alpha;
                    __builtin_amdgcn_wave_barrier();
#pragma unroll
                    for (int r = 0; r < 16; ++r) { const float f = wsf[crow(r, hi)]; o0[r] *= f; o1[r] *= f; }
                    __builtin_amdgcn_wave_barrier();
                }
            } else {
                sb_sub(p1, k0 + 32, tq, hi, needmask, R);
                sb_sub(p0, k0, tq, hi, needmask, R);
            }
            const int vlane = ((lane >> 4) & 1) * 32 + (lane & 3) * 8, kq = 4 * hi + ((lane & 15) >> 2);
#pragma unroll
            for (int sub = 0; sub < 2; ++sub)
#pragma unroll
                for (int s = 0; s < 2; ++s) {
                    v4u pw;
                    if (sub == 0) { pw.x = cvtpk(p0[8 * s], p0[8 * s + 1]); pw.y = cvtpk(p0[8 * s + 2], p0[8 * s + 3]); pw.z = cvtpk(p0[8 * s + 4], p0[8 * s + 5]); pw.w = cvtpk(p0[8 * s + 6], p0[8 * s + 7]); }
                    else { pw.x = cvtpk(p1[8 * s], p1[8 * s + 1]); pw.y = cvtpk(p1[8 * s + 2], p1[8 * s + 3]); pw.z = cvtpk(p1[8 * s + 4], p1[8 * s + 5]); pw.w = cvtpk(p1[8 * s + 6], p1[8 * s + 7]); }
                    const bf16x8 pa = __builtin_bit_cast(bf16x8, pw);
                    const int key0 = 32 * sub + 16 * s + kq, sw = (key0 >> 1) & 1;
#pragma unroll
                    for (int db = 0; db < 2; ++db) {
                        const LAS unsigned char* va = Vb + key0 * 128 + ((db ^ sw) * 64) + vlane;
                        const s16x4 lo = vtr(va), hh = vtr(va + 8 * 128);
                        const bf16x8 vf = (bf16x8){lo[0], lo[1], lo[2], lo[3], hh[0], hh[1], hh[2], hh[3]};
                        if (db == 0) o0 = __builtin_amdgcn_mfma_f32_32x32x16_bf16(pa, vf, o0, 0, 0, 0); else o1 = __builtin_amdgcn_mfma_f32_32x32x16_bf16(pa, vf, o1, 0, 0, 0);
                    }
                }
        }
        if (!wdone) {
            if (!more) wdone = true;
            else if (FOX) { const float bound = qn * knmax + cq - CUM[k0 - 1]; wdone = __all(bound < mrun - 30.f); }
            else wdone = __all(R < -30.f);
        }
        LAS unsigned* flg = (LAS unsigned*)(L + A0_FLAG) + (kt & 1) * 8;
        if (lane == 0) flg[wave] = wdone ? 1u : 0u;
        if (more) { const int o = (buf ^ 1) * 8192; *(LAS v4u*)(L + kdst + o) = kreg; *(LAS v4u*)(L + vdst + o) = vreg; if (FOX && tid < 64) ((LAS float*)(L + A0_CK))[(buf ^ 1) * 64 + tid] = ckreg; }
        __syncthreads();
        if (!more) break;
        unsigned alld = 1u;
#pragma unroll
        for (int w = 0; w < 8; ++w) alld &= flg[w];
        if (alld) break;
        buf ^= 1;
    }
    float inv = 1.f;
    if (FOX) { const float lt = lrun + __shfl_xor(lrun, 32); inv = 1.f / lt; }
    if (hi == 0) wsf[r32] = inv;
    __builtin_amdgcn_wave_barrier();
#pragma unroll
    for (int r = 0; r < 16; ++r) { const float f = wsf[crow(r, hi)]; bf16* op = Og + (rowbase + qmin + crow(r, hi)) * DM + h * 64 + r32;
        op[0] = (bf16)f2bf(o0[r] * f); op[32] = (bf16)f2bf(o1[r] * f); }
    __syncthreads();
}
__device__ __forceinline__ void p2_attention(Frame& F) {
    for (int u = F.vcu; u < 512; u += F.G) attn0_unit<true>(F, u >> 8, 8 + ((u >> 5) & 7), u & 31);
    for (int u = F.vcu; u < 512; u += F.G) attn0_unit<false>(F, u >> 8, (u >> 5) & 7, u & 31);
}
constexpr int IX_CAP = 1024, IX_TRIG = IX_CAP - 256;
constexpr int IX_QS = 0, IX_SC = 36864, IX_ID = IX_SC + 16 * IX_CAP * 4, IX_CNT = IX_ID + 16 * IX_CAP * 2, IX_TAU = IX_CNT + 64;
static_assert(IX_TAU + 64 <= RING_BYTES, "indexer LDS");
__device__ __forceinline__ unsigned mono_key(float f) { const unsigned u = __float_as_uint(f); return (u & 0x80000000u) ? ~u : (u | 0x80000000u); }
__device__ __forceinline__ float mono_inv(unsigned k) { return __uint_as_float((k & 0x80000000u) ? (k & 0x7fffffffu) : ~k); }
__device__ __forceinline__ int wave_sum_dpp(int v) {
    v += __builtin_amdgcn_update_dpp(0, v, 0xB1, 0xF, 0xF, false);
    v += __builtin_amdgcn_update_dpp(0, v, 0x4E, 0xF, 0xF, false);
    v += __builtin_amdgcn_update_dpp(0, v, 0x141, 0xF, 0xF, false);
    v += __builtin_amdgcn_update_dpp(0, v, 0x140, 0xF, 0xF, false);
    return __builtin_amdgcn_readlane(v, 0) + __builtin_amdgcn_readlane(v, 16) + __builtin_amdgcn_readlane(v, 32) + __builtin_amdgcn_readlane(v, 48);
}
__device__ __forceinline__ float select256(LAS float* sc, LAS u16* id, int n, int lane_, bool exact, int* cnt_out) {
    constexpr int NE = IX_CAP / 64;
    const int lane = opaque(lane_), nl = n - lane;
    unsigned key[NE]; u16 idv[NE];
#pragma unroll
    for (int j = 0; j < NE; ++j) { const bool valid = 64 * j < nl; key[j] = valid ? mono_key(sc[lane + 64 * j]) : 0u; idv[j] = valid ? id[lane + 64 * j] : (u16)0; }
    unsigned T = 0u; int cntT = n; bool full = true;
#pragma unroll 1
    for (int bit = 31; bit >= 0; --bit) {
        const unsigned cand = T | (1u << bit); int tot = 0;
        unsigned long long mk[NE];
#pragma unroll
        for (int j = 0; j < NE; ++j) asm volatile("v_cmp_le_u32 %0, %1, %2" : "=s"(mk[j]) : "s"(cand), "v"(key[j]));
#pragma unroll
        for (int j = 0; j < NE; ++j) tot += __popcll(mk[j]);
        if (tot >= 256) { T = cand; cntT = tot; }
        if (!exact && bit <= 16 && bit > 0 && cntT <= 384 && T > 1u) { full = false; break; }
    }
    const unsigned Te = full ? T : T - 1u;
    int cg = 0, ce = 0;
#pragma unroll
    for (int j = 0; j < NE; ++j) { cg += (key[j] > Te) ? 1 : 0; ce += (key[j] == Te) ? 1 : 0; }
    int pk = cg | (ce << 16), inc = pk;
#pragma unroll
    for (int o = 1; o < 64; o <<= 1) { const int u = __shfl_up(inc, o); if (lane >= o) inc += u; }
    const int totp = __builtin_amdgcn_readlane(inc, 63), above = totp & 0xffff;
    const int kk = full ? 256 - above : 0;
    int pg = (inc - pk) & 0xffff, pe = (inc - pk) >> 16;
#pragma unroll
    for (int j = 0; j < NE; ++j) {
        const bool gt = key[j] > Te, eq = (key[j] == Te) && (pe < kk);
        if (gt) { sc[pg] = mono_inv(key[j]); id[pg] = idv[j]; }
        if (eq) { sc[above + pe] = mono_inv(key[j]); id[above + pe] = idv[j]; }
        pg += gt ? 1 : 0; pe += (key[j] == Te) ? 1 : 0;
    }
    *cnt_out = above + (kk > 0 ? kk : 0);
    return mono_inv(Te);
}
__device__ __forceinline__ void idx_unit(Frame& F, int b, int qg) {
    LAS unsigned char* L = F.lds + RING_OFF;
    const int tid = opaque(F.tid), lane = tid & 63, wave = F.wave, r32 = lane & 31, hi = lane >> 5, q = lane & 15, hsel = (lane >> 4) & 1;
    const size_t rowbase = (size_t)b * SEQ; const int t0 = qg * 16, nvis = ((t0 >> 6) + 1) * 64;
    const bf16* QI = (const bf16*)(F.ws + WS_QI); const bf16* KI = (const bf16*)(F.ws + WS_KI); const float* WI = (const float*)(F.ws + WS_WI); u16* IDX = (u16*)(F.ws + WS_IDX);
    LAS float* SC = (LAS float*)(L + IX_SC); LAS u16* ID = (LAS u16*)(L + IX_ID); LAS unsigned* CNT = (LAS unsigned*)(L + IX_CNT); LAS float* TAU = (LAS float*)(L + IX_TAU);
#pragma unroll
    for (int i = 0; i < 4; ++i) { const int ci = tid + 512 * i, qq = ci >> 7, rem = ci & 127, hh = rem >> 3, ch = rem & 7;
        *(LAS v4u*)(L + IX_QS + (hh * 16 + qq) * 144 + ch * 16) = *(const GAS v4u*)(QI + (rowbase + t0 + qq) * 1024 + hh * 64 + ch * 8); }
    if (tid < 16) { CNT[tid] = 0u; TAU[tid] = -INFINITY; }
    float wv[8];
#pragma unroll
    for (int hp = 0; hp < 8; ++hp) wv[hp] = WI[(rowbase + t0 + q) * 16 + 2 * hp + hsel];
    __syncthreads();
    bf16x8 afn[4];
#pragma unroll
    for (int ks = 0; ks < 4; ++ks) afn[ks] = *(const GAS bf16x8*)(KI + (rowbase + wave * 32 + r32) * 64 + 16 * ks + 8 * hi);
    for (int r0 = 0; r0 < nvis; r0 += 256) {
        const int kbase = r0 + wave * 32;
        bf16x8 af[4];
#pragma unroll
        for (int ks = 0; ks < 4; ++ks) af[ks] = afn[ks];
        if (kbase + 256 < nvis) {
#pragma unroll
            for (int ks = 0; ks < 4; ++ks) afn[ks] = *(const GAS bf16x8*)(KI + (rowbase + kbase + 256 + r32) * 64 + 16 * ks + 8 * hi); }
        if (kbase < nvis) {
            f32x16 acc;
#pragma unroll
            for (int r = 0; r < 16; ++r) acc[r] = 0.f;
#pragma unroll
            for (int hp = 0; hp < 8; hp += 2) {
                f32x16 c0, c1;
#pragma unroll
                for (int r = 0; r < 16; ++r) { c0[r] = 0.f; c1[r] = 0.f; }
                const LAS unsigned char* q0p = L + IX_QS + ((2 * hp + hsel) * 16 + q) * 144 + hi * 16;
                const LAS unsigned char* q1p = q0p + 2 * 16 * 144;
#pragma unroll
                for (int ks = 0; ks < 4; ++ks) { const bf16x8 b0 = *(const LAS bf16x8*)(q0p + ks * 32), b1 = *(const LAS bf16x8*)(q1p + ks * 32);
                    c0 = __builtin_amdgcn_mfma_f32_32x32x16_bf16(af[ks], b0, c0, 0, 0, 0); c1 = __builtin_amdgcn_mfma_f32_32x32x16_bf16(af[ks], b1, c1, 0, 0, 0); }
#pragma unroll
                for (int r = 0; r < 16; ++r) { const int i0 = __float_as_int(c0[r]), i1 = __float_as_int(c1[r]); const float y0 = __int_as_float(i0 > 0 ? i0 : 0), y1 = __int_as_float(i1 > 0 ? i1 : 0); acc[r] += wv[hp] * y0; acc[r] += wv[hp + 1] * y1; }
                __builtin_amdgcn_sched_barrier(0);
            }
#pragma unroll
            for (int r = 0; r < 16; ++r) acc[r] += __shfl_xor(acc[r], 16);
            const float tau = TAU[q];
            float sv[8]; int np = 0;
#pragma unroll
            for (int j = 0; j < 8; ++j) { sv[j] = hsel ? acc[8 + j] : acc[j]; np += (sv[j] > tau) ? 1 : 0; }
            if (np > 0) {
                unsigned pos = atomicAdd((unsigned*)(CNT + q), (unsigned)np);
                const int kb0 = kbase + 16 * hsel + 4 * hi;
#pragma unroll
                for (int j = 0; j < 8; ++j) if (sv[j] > tau) { SC[q * IX_CAP + pos] = sv[j]; ID[q * IX_CAP + pos] = (u16)(kb0 + (j & 3) + 8 * (j >> 2)); ++pos; }
            }
        }
        __syncthreads();
        unsigned mx = CNT[lane & 15];
#pragma unroll
        for (int o = 1; o < 16; o <<= 1) { const unsigned u = (unsigned)__shfl_xor((int)mx, o); mx = u > mx ? u : mx; }
        const bool last = r0 + 256 >= nvis;
        if (mx > (unsigned)IX_TRIG || last) {
#pragma unroll 1
            for (int qq = 2 * wave; qq < 2 * wave + 2; ++qq) { const int n = (int)CNT[qq];
                if (n > 256) { int nc; const float t = select256(SC + qq * IX_CAP, ID + qq * IX_CAP, n, lane, last, &nc); if (lane == 0) { CNT[qq] = (unsigned)nc; TAU[qq] = t; } } } }
        __syncthreads();
    }
    { const int qq = tid >> 5, n = (int)CNT[qq];
#pragma unroll
      for (int j = 0; j < 8; ++j) { const int i = (tid & 31) + 32 * j; IDX[(rowbase + t0 + qq) * 256 + i] = i < n ? ID[qq * IX_CAP + i] : (u16)0xFFFF; } }
    __syncthreads();
}
__device__ __forceinline__ void p10_indexer(Frame& F) {
    for (int i = 0; i < 1024; i += F.G) {
        const int s = i + F.vcu; if (s >= 1024) break;
        const int j = s >> 8, c = s & 255;
        const int v = (j == 0) ? c : (j == 1) ? 511 - c : (j == 2) ? 512 + c : 1023 - c;
        idx_unit(F, v & 1, v >> 1);
    }
}
constexpr int SP_ROWB = 544, SP_WAVE_BYTES = 32 * SP_ROWB;
static_assert(NWAVES * SP_WAVE_BYTES <= RING_BYTES, "sparse attention LDS");
__device__ __forceinline__ void sparse_query(Frame& F, int row) {
    const int lane = opaque(F.lane), r16 = lane & 15, g = lane >> 4, b = row >> 13, row8 = lane >> 3, p8 = lane & 7;
    LAS unsigned char* vb = F.lds + RING_OFF + F.wave * SP_WAVE_BYTES;
    const u16* ix = (const u16*)(F.ws + WS_IDX) + (size_t)row * 256;
    bf16* qrow = (bf16*)(F.ws + WS_QD) + (size_t)row * 4096;
    const bf16* KL = (const bf16*)(F.ws + WS_KL) + (size_t)b * SEQ * 256;
    bf16x8 qf[8];
#pragma unroll
    for (int ks = 0; ks < 8; ++ks) qf[ks] = *(const GAS bf16x8*)(qrow + r16 * 256 + 32 * ks + 8 * g);
    f32x4 ctx[12];
#pragma unroll
    for (int ct = 0; ct < 12; ++ct) ctx[ct] = (f32x4){0.f, 0.f, 0.f, 0.f};
    float mrun = -INFINITY, lrun = 0.f;
    const int trd = (4 * g + (r16 >> 2)) * SP_ROWB + 128 + (r16 & 3) * 8;
    v4u gr[4][4];
#define SP_GATHER(s_) do { _Pragma("unroll") for (int i_ = 0; i_ < 4; ++i_) { const unsigned key_ = ix[32 * (s_) + 8 * i_ + row8]; \
        const bf16* kp_ = KL + (size_t)(key_ == 0xFFFFu ? 0u : key_) * 256 + 8 * p8; \
        _Pragma("unroll") for (int c_ = 0; c_ < 4; ++c_) gr[i_][c_] = *(const GAS v4u*)(kp_ + 64 * c_); } } while (0)
    SP_GATHER(0);
#pragma unroll 1
    for (int s = 0; s < 8; ++s) {
#pragma unroll
        for (int i = 0; i < 4; ++i)
#pragma unroll
            for (int c = 0; c < 4; ++c) *(LAS v4u*)(vb + (8 * i + row8) * SP_ROWB + c * 128 + p8 * 16) = gr[i][c];
        if (s < 7) SP_GATHER(s + 1);
        f32x4 S0 = (f32x4){0.f, 0.f, 0.f, 0.f}, S1 = S0;
#pragma unroll
        for (int ks = 0; ks < 8; ++ks) {
            const bf16x8 a0 = *(const LAS bf16x8*)(vb + r16 * SP_ROWB + (32 * ks + 8 * g) * 2), a1 = *(const LAS bf16x8*)(vb + (16 + r16) * SP_ROWB + (32 * ks + 8 * g) * 2);
            S0 = __builtin_amdgcn_mfma_f32_16x16x32_bf16(a0, qf[ks], S0, 0, 0, 0); S1 = __builtin_amdgcn_mfma_f32_16x16x32_bf16(a1, qf[ks], S1, 0, 0, 0);
        }
        const v2u i0 = *(const GAS v2u*)(ix + 32 * s + 4 * g), i1 = *(const GAS v2u*)(ix + 32 * s + 16 + 4 * g);
        float x[8];
        x[0] = (i0.x & 0xffffu) == 0xffffu ? -INFINITY : S0[0] * DSA_SCALE; x[1] = (i0.x >> 16) == 0xffffu ? -INFINITY : S0[1] * DSA_SCALE;
        x[2] = (i0.y & 0xffffu) == 0xffffu ? -INFINITY : S0[2] * DSA_SCALE; x[3] = (i0.y >> 16) == 0xffffu ? -INFINITY : S0[3] * DSA_SCALE;
        x[4] = (i1.x & 0xffffu) == 0xffffu ? -INFINITY : S1[0] * DSA_SCALE; x[5] = (i1.x >> 16) == 0xffffu ? -INFINITY : S1[1] * DSA_SCALE;
        x[6] = (i1.y & 0xffffu) == 0xffffu ? -INFINITY : S1[2] * DSA_SCALE; x[7] = (i1.y >> 16) == 0xffffu ? -INFINITY : S1[3] * DSA_SCALE;
        float cm = fmaxf(fmaxf(fmaxf(x[0], x[1]), fmaxf(x[2], x[3])), fmaxf(fmaxf(x[4], x[5]), fmaxf(x[6], x[7])));
        cm = fmaxf(cm, __shfl_xor(cm, 16)); cm = fmaxf(cm, __shfl_xor(cm, 32));
        const float mnew = fmaxf(mrun, cm), alpha = __expf(mrun - mnew);
        float ps = 0.f;
#pragma unroll
        for (int i = 0; i < 8; ++i) { x[i] = __expf(x[i] - mnew); ps += x[i]; }
        lrun = lrun * alpha + ps; mrun = mnew;
        if (__any(alpha != 1.f)) {
#pragma unroll
            for (int ct = 0; ct < 12; ++ct) ctx[ct] = ctx[ct] * alpha; }
        const v4u pw = (v4u){cvtpk(x[0], x[1]), cvtpk(x[2], x[3]), cvtpk(x[4], x[5]), cvtpk(x[6], x[7])};
        const bf16x8 pf = __builtin_bit_cast(bf16x8, pw);
#pragma unroll
        for (int ct = 0; ct < 12; ++ct) {
            const s16x4 lo = vtr(vb + trd + ct * 32), hh = vtr(vb + trd + 16 * SP_ROWB + ct * 32);
            const bf16x8 vf = (bf16x8){lo[0], lo[1], lo[2], lo[3], hh[0], hh[1], hh[2], hh[3]};
            ctx[ct] = __builtin_amdgcn_mfma_f32_16x16x32_bf16(vf, pf, ctx[ct], 0, 0, 0);
        }
    }
#undef SP_GATHER
    lrun += __shfl_xor(lrun, 16); lrun += __shfl_xor(lrun, 32);
    const float inv = 1.f / lrun;
#pragma unroll
    for (int ct = 0; ct < 12; ++ct) { const f32x4 v = ctx[ct] * inv; *(GAS v2u*)(qrow + r16 * 192 + 16 * ct + 4 * g) = (v2u){cvtpk(v[0], v[1]), cvtpk(v[2], v[3])}; }
}
__device__ __forceinline__ void p11_sparse(Frame& F) {
    const int gw = F.vcu * NWAVES + F.wave, NGW = F.G * NWAVES;
    for (int row = gw; row < M; row += NGW) sparse_query(F, row);
}
constexpr int REP_P0 = 1, REP_P2 = 1, REP_P10 = 1;
__global__ void __launch_bounds__(NWAVES * 64, 2) mk_fwd(Args args) {
    extern __shared__ __attribute__((aligned(16))) unsigned char lds[];
    Frame F;
    F.lds = (LAS unsigned char*)lds;
    F.MISC = (volatile LAS unsigned*)(F.lds + MISC_OFF);
    F.tid = threadIdx.x; F.lane = F.tid & 63; F.wave = __builtin_amdgcn_readfirstlane(F.tid >> 6);
    F.G = gridDim.x; { const int bx = blockIdx.x; F.vcu = (F.G % 8 == 0) ? (bx % 8) * (F.G / 8) + bx / 8 : bx; }
    F.ws = args.ws; F.out = args.out; F.ctl = (gu32*)(args.ws + WS_CTL);
    for (int u = F.tid; u < (LDS_BYTES - LDSCTL_OFF) / 4; u += NWAVES * 64) ((LAS unsigned*)(F.lds + LDSCTL_OFF))[u] = 0u;
    __syncthreads();
    XcdBarrier bar = xcd_barrier_post((unsigned*)(F.ctl + CW_BAR), F.MISC + 8);
#define GRID_BAR() xcd_barrier(bar)
    unsigned char* ws = args.ws;
    bf16* XB = (bf16*)(ws + WS_XB); bf16* HB = (bf16*)(ws + WS_H);
    const int bx = (int)blockIdx.x;

    for (int rep = 0; rep < REP_P0; ++rep) p0_prologue(F);
    GRID_BAR();
    {   pg8::Gemm g{XB, (const bf16*)(ws + WS_W0IN), M, NQKV0, DM, DM}; pg8::StaticOrder S; S.init(M, NQKV0, F.G, bx);
        pg8::EpiBf16<0> E{(bf16*)(ws + WS_QO), DM, nullptr, DM, (size_t)(WS_K - WS_QO) / 2, 0.125f};
        pg8::gemm_phase<pg8::EpiBf16<0>, pg8::StaticOrder, PG8_ALIGN, PG8_SP2>(F.lds + RING_OFF, g, S, E); }
    GRID_BAR();
    p1b_scan_kn(F);
    GRID_BAR();
    for (int rep = 0; rep < REP_P2; ++rep) p2_attention(F);
    GRID_BAR();
    {   pg8::Gemm g{XB, (const bf16*)(ws + WS_W0O), M, DM, DM, DM}; pg8::StaticOrder S; S.init(M, DM, F.G, bx);
        pg8::EpiResF32 E{argp(0), F.out, DM, ALPHA};
        pg8::gemm_phase<pg8::EpiResF32, pg8::StaticOrder, PG8_ALIGN, PG8_SP2>(F.lds + RING_OFF, g, S, E); }
    GRID_BAR();
    ln_phase(F, F.out, argp(5), argp(6), XB);
    GRID_BAR();
    {   pg8::Gemm g{XB, (const bf16*)(ws + WS_W0UP), M, FF2, DM, DM}; pg8::HaloOrder S; S.init(65, FF2, F.G, bx);
        pg8::EpiConvGate E{HB, FF, argp(8), argp(9), FF, (LAS float*)(F.lds + HALO_OFF), M, SEQ - 1};
        pg8::gemm_phase<pg8::EpiConvGate, pg8::HaloOrder, true, PG8_SP2>(F.lds + RING_OFF, g, S, E); }
    GRID_BAR();
    {   pg8::Gemm g{HB, (const bf16*)(ws + WS_W0DN), M, DM, FF, FF}; pg8::StaticOrder S; S.init(M, DM, F.G, bx);
        pg8::EpiResF32 E{F.out, F.out, DM, ALPHA};
        pg8::gemm_phase<pg8::EpiResF32, pg8::StaticOrder, PG8_ALIGN, PG8_SP2>(F.lds + RING_OFF, g, S, E); }
    GRID_BAR();
    ln_phase(F, F.out, argp(11), argp(12), XB);
    p8_prep(F);
    GRID_BAR();
    {   pg8::Gemm g{XB, (const bf16*)(ws + WS_W1IN), M, N1PAD, DM, DM}; pg8::StaticOrder S; S.init(M, N1PAD, F.G, bx);
        pg8::EpiL1In E{(bf16*)(ws + WS_QD), (bf16*)(ws + WS_KL), (bf16*)(ws + WS_QI), (bf16*)(ws + WS_KI), (float*)(ws + WS_WI), (const float*)(ws + WS_CSQ), (const float*)(ws + WS_CSI), IDX_SCALE};
        pg8::gemm_phase<pg8::EpiL1In, pg8::StaticOrder, PG8_ALIGN, PG8_SP2>(F.lds + RING_OFF, g, S, E); }
    GRID_BAR();
    for (int rep = 0; rep < REP_P10; ++rep) p10_indexer(F);
    GRID_BAR();
    p11_sparse(F);
    GRID_BAR();
    {   pg8::Gemm g{(const bf16*)(ws + WS_QD), (const bf16*)(ws + WS_WC), M, DM, 3072, 4096}; pg8::StaticOrder S; S.init(M, DM, F.G, bx);
        pg8::EpiResF32 E{F.out, F.out, DM, ALPHA};
        pg8::gemm_phase<pg8::EpiResF32, pg8::StaticOrder, PG8_ALIGN, PG8_SP2>(F.lds + RING_OFF, g, S, E); }
    GRID_BAR();
    ln_phase(F, F.out, argp(16), argp(17), XB);
    GRID_BAR();
    {   pg8::Gemm g{XB, (const bf16*)(ws + WS_W1UP), M, FF2, DM, DM}; pg8::HaloOrder S; S.init(65, FF2, F.G, bx);
        pg8::EpiConvGate E{HB, FF, argp(19), argp(20), FF, (LAS float*)(F.lds + HALO_OFF), M, SEQ - 1};
        pg8::gemm_phase<pg8::EpiConvGate, pg8::HaloOrder, true, PG8_SP2>(F.lds + RING_OFF, g, S, E); }
    GRID_BAR();
    {   pg8::Gemm g{HB, (const bf16*)(ws + WS_W1DN), M, DM, FF, FF}; pg8::StaticOrder S; S.init(M, DM, F.G, bx);
        pg8::EpiResF32 E{F.out, F.out, DM, ALPHA};
        pg8::gemm_phase<pg8::EpiResF32, pg8::StaticOrder, PG8_ALIGN, PG8_SP2>(F.lds + RING_OFF, g, S, E); }
    GRID_BAR();
    ln_phase(F, F.out, argp(22), argp(23), nullptr);
#undef GRID_BAR
}

extern "C" void kernel_launch(void* const* d_in, const int* in_sizes, int n_in, void* d_out, int out_size, void* d_ws, size_t ws_size, hipStream_t stream) {
    static int grid = 0;
    if (grid == 0) {
        if (n_in != NIN || in_sizes[0] != M * DM || out_size != M * DM || ws_size < WS_END) { fprintf(stderr, "kernel_launch: unexpected shapes (n_in %d, in0 %d, out %d, ws %zu); nothing launched\n", n_in, n_in > 0 ? in_sizes[0] : -1, out_size, ws_size); grid = -1; return; }
        int dev = 0, cus = 0, per_cu = 0;
        if (hipGetDevice(&dev) != hipSuccess || hipDeviceGetAttribute(&cus, hipDeviceAttributeMultiprocessorCount, dev) != hipSuccess) { grid = -1; return; }
        if (hipFuncSetAttribute((const void*)mk_fwd, hipFuncAttributeMaxDynamicSharedMemorySize, LDS_BYTES) != hipSuccess) { fprintf(stderr, "kernel_launch: hipFuncSetAttribute failed\n"); grid = -1; return; }
        if (hipOccupancyMaxActiveBlocksPerMultiprocessor(&per_cu, (const void*)mk_fwd, NWAVES * 64, LDS_BYTES) != hipSuccess || per_cu < 1) fprintf(stderr, "kernel_launch: occupancy query reports %d workgroups per CU\n", per_cu);
        (void)hipGetLastError();
        grid = cus;
    }
    if (grid < 0) return;
    if (hipMemsetAsync((char*)d_ws + WS_CTL, 0, CTL_ZERO_BYTES, stream) != hipSuccess) { fprintf(stderr, "kernel_launch: hipMemsetAsync failed\n"); return; }
    Args a{};
    for (int i = 0; i < NIN; ++i) a.in[i] = (const float*)d_in[i];
    a.out = (float*)d_out; a.ws = (unsigned char*)d_ws;
    hipLaunchKernelGGL(mk_fwd, dim3(grid), dim3(NWAVES * 64), LDS_BYTES, stream, a);
    const hipError_t le = hipPeekAtLastError();
    if (le != hipSuccess) fprintf(stderr, "kernel_launch: launch failed: %s\n", hipGetErrorName(le));
}
```
